# Optimizing an MI355X kernel written in HIP

```python
import jax, jax.numpy as jnp
from jax import lax
import numpy as np

D_MODEL = 4096
BATCH = 2
SEQ = 4096
DEPTH = 2

CTX_LEN = 256
GRID_W = 64
HEAD_DIM = 128
EPS = 1e-6
ROPE_THETA = 10000.0
Q_BLOCK = 128
N_MOD = 9
D_FF = 10240
NA_HEADS = 16
NA_WIN_H = 8
NA_WIN_W = 16
GQA_Q_HEADS = 16
GQA_KV_HEADS = 4
GQA_GROUP = GQA_Q_HEADS // GQA_KV_HEADS
NA_WIDTH = NA_HEADS * HEAD_DIM
GQA_Q_WIDTH = GQA_Q_HEADS * HEAD_DIM
GQA_KV_WIDTH = GQA_KV_HEADS * HEAD_DIM
EV_Q_COLS = NA_WIDTH + GQA_Q_WIDTH
EV_KV_COLS = 2 * NA_WIDTH + 2 * GQA_KV_WIDTH
MLA_HEADS = 32
MLA_Q_RANK = 1024
MLA_KV_RANK = 512
MLA_NOPE = 128
MLA_ROPE = 64
MLA_V = 128

kernel_name = "hybrid_natten_gqa_mla_macaron_dit"


def rms_norm(x, g):
    xf = x.astype(jnp.float32)
    y = xf * lax.rsqrt(jnp.mean(xf * xf, axis=-1, keepdims=True) + EPS)
    return (y * g.astype(jnp.float32)).astype(x.dtype)


def modulate(h, g, shift, scale):
    return rms_norm(h, g) * (1.0 + scale) + shift


def swiglu(h, w1, w2):
    gate, up = jnp.split(h @ w1, 2, axis=-1)
    return (jax.nn.silu(gate) * up) @ w2


def heads(t, n):
    return t.reshape(*t.shape[:-1], n, -1)


def axial_angles(n_tok, rot_dim):
    t = jnp.arange(n_tok)
    row = (t // GRID_W).astype(jnp.float32)
    col = (t % GRID_W).astype(jnp.float32)
    axis_dim = rot_dim // 2
    inv_freq = ROPE_THETA ** (-jnp.arange(0, axis_dim, 2, dtype=jnp.float32) / axis_dim)
    ang = jnp.concatenate([row[:, None] * inv_freq, col[:, None] * inv_freq], axis=-1)
    return jnp.cos(ang), jnp.sin(ang)


def apply_rope(x, cos, sin):
    x1, x2 = jnp.split(x, 2, axis=-1)
    cs = cos[None, :, None, :].astype(x.dtype)
    sn = sin[None, :, None, :].astype(x.dtype)
    return jnp.concatenate([x1 * cs - x2 * sn, x1 * sn + x2 * cs], axis=-1)


def sweep_attention(q, k, v):
    B, S = q.shape[0], q.shape[1]
    scale = q.shape[-1] ** -0.5
    nb = S // Q_BLOCK
    qb = q.reshape(B, nb, Q_BLOCK, *q.shape[2:]).swapaxes(0, 1)

    def one_block(qblk):
        s = jnp.einsum("bqhgd,bkhd->bhgqk", qblk, k).astype(jnp.float32) * scale
        p = jax.nn.softmax(s, axis=-1).astype(v.dtype)
        return jnp.einsum("bhgqk,bkhd->bqhgd", p, v)

    ob = lax.map(one_block, qb)
    return ob.swapaxes(0, 1).reshape(B, S, *ob.shape[3:])


def neighbourhood_attention(q, k, v, k_ctx, v_ctx, rpb):
    B, S, H, Dh = q.shape
    rows = S // GRID_W
    kh = min(NA_WIN_H, rows)
    kw = NA_WIN_W
    scale = Dh ** -0.5
    qg = q.reshape(B, rows, GRID_W, H, Dh)
    kg = k.reshape(B, rows, GRID_W, H, Dh)
    vg = v.reshape(B, rows, GRID_W, H, Dh)
    col = jnp.arange(GRID_W)
    c0 = jnp.clip(col - kw // 2, 0, GRID_W - kw)
    col_mask = (col[None, :] >= c0[:, None]) & (col[None, :] < c0[:, None] + kw)
    col_idx = jnp.clip(col[None, :] - col[:, None] + NA_WIN_W - 1, 0, 2 * NA_WIN_W - 2)
    rpb_cols = rpb[:, :, col_idx]
    band = jnp.arange(kh)

    def one_row(r):
        r0 = jnp.clip(r - kh // 2, 0, rows - kh)
        qr = lax.dynamic_index_in_dim(qg, r, axis=1, keepdims=False)
        kb = lax.dynamic_slice_in_dim(kg, r0, kh, axis=1)
        vb = lax.dynamic_slice_in_dim(vg, r0, kh, axis=1)
        bias = jnp.take(rpb_cols, r0 + band - r + NA_WIN_H - 1, axis=1)
        s_band = jnp.einsum("bqhd,bikhd->bhqik", qr, kb).astype(jnp.float32) * scale
        s_band = s_band + bias.transpose(0, 2, 1, 3)[None].astype(jnp.float32)
        s_band = jnp.where(col_mask[None, None, :, None, :], s_band, -jnp.inf)
        s_ctx = jnp.einsum("bqhd,bchd->bhqc", qr, k_ctx).astype(jnp.float32) * scale
        s = jnp.concatenate([s_band.reshape(B, H, GRID_W, kh * GRID_W), s_ctx], axis=-1)
        p = jax.nn.softmax(s, axis=-1).astype(v.dtype)
        p_band = p[..., :kh * GRID_W].reshape(B, H, GRID_W, kh, GRID_W)
        p_ctx = p[..., kh * GRID_W:]
        return (jnp.einsum("bhqik,bikhd->bqhd", p_band, vb)
                + jnp.einsum("bhqc,bchd->bqhd", p_ctx, v_ctx))

    out = lax.map(one_row, jnp.arange(rows))
    return out.transpose(1, 0, 2, 3, 4).reshape(B, S, H, Dh)


def even_mixer(ul, uc, w_in, w_out, na_q_g, na_k_g, rpb, gq_q_g, gq_k_g, cos, sin, ctx_out):
    B, S, _ = ul.shape

    def split_q(p):
        na_q, gq_q = jnp.split(p, [NA_WIDTH], axis=-1)
        return rms_norm(heads(na_q, NA_HEADS), na_q_g), rms_norm(heads(gq_q, GQA_Q_HEADS), gq_q_g)

    def split_kv(p):
        na_k, na_v, gq_k, gq_v = jnp.split(p, [NA_WIDTH, 2 * NA_WIDTH, 2 * NA_WIDTH + GQA_KV_WIDTH], axis=-1)
        return (rms_norm(heads(na_k, NA_HEADS), na_k_g), heads(na_v, NA_HEADS),
                rms_norm(heads(gq_k, GQA_KV_HEADS), gq_k_g), heads(gq_v, GQA_KV_HEADS))

    pl = ul @ w_in
    na_q, gq_q = split_q(pl[..., :EV_Q_COLS])
    na_k, na_v, gq_k, gq_v = split_kv(pl[..., EV_Q_COLS:])
    pc = uc @ (w_in if ctx_out else w_in[:, EV_Q_COLS:])
    na_kc, na_vc, gq_kc, gq_vc = split_kv(pc[..., -EV_KV_COLS:])
    a = neighbourhood_attention(na_q, na_k, na_v, na_kc, na_vc, rpb)
    q_rot = apply_rope(gq_q, cos, sin).reshape(B, S, GQA_KV_HEADS, GQA_GROUP, HEAD_DIM)
    keys = jnp.concatenate([gq_kc, apply_rope(gq_k, cos, sin)], axis=1)
    vals = jnp.concatenate([gq_vc, gq_v], axis=1)
    b = sweep_attention(q_rot, keys, vals)
    out_l = jnp.concatenate([a.reshape(B, S, NA_WIDTH), b.reshape(B, S, GQA_Q_WIDTH)], axis=-1) @ w_out
    if not ctx_out:
        return out_l, None
    L = uc.shape[1]
    na_qc, gq_qc = split_q(pc[..., :EV_Q_COLS])
    ac = sweep_attention(na_qc[:, :, :, None, :], na_kc, na_vc)
    bc = sweep_attention(gq_qc.reshape(B, L, GQA_KV_HEADS, GQA_GROUP, HEAD_DIM), gq_kc, gq_vc)
    out_c = jnp.concatenate([ac.reshape(B, L, NA_WIDTH), bc.reshape(B, L, GQA_Q_WIDTH)], axis=-1) @ w_out
    return out_l, out_c


def mla_mixer(ul, uc, w_down, q_a_g, kv_a_g, w_uq, w_ukv, qn_g, qr_g, kn_g, kr_g, w_o, cos, sin, ctx_out):
    B, S, _ = ul.shape

    def queries(cq):
        q = heads(rms_norm(cq, q_a_g) @ w_uq, MLA_HEADS)
        q_nope, q_rope = jnp.split(q, [MLA_NOPE], axis=-1)
        return rms_norm(q_nope, qn_g), rms_norm(q_rope, qr_g)

    def keys_values(ckv, k_rope):
        kv = heads(rms_norm(ckv, kv_a_g) @ w_ukv, MLA_HEADS)
        k_nope, v = jnp.split(kv, [MLA_NOPE], axis=-1)
        return rms_norm(k_nope, kn_g), rms_norm(k_rope, kr_g)[:, :, None, :], v

    def join(nope, rope):
        return jnp.concatenate([nope, jnp.broadcast_to(rope, nope.shape[:-1] + rope.shape[-1:])], axis=-1)

    dl = ul @ w_down
    q_nope, q_rope = queries(dl[..., :MLA_Q_RANK])
    k_nope, k_rope, v = keys_values(dl[..., MLA_Q_RANK:MLA_Q_RANK + MLA_KV_RANK], dl[..., MLA_Q_RANK + MLA_KV_RANK:])
    dc = uc @ (w_down if ctx_out else w_down[:, MLA_Q_RANK:])
    kc_nope, kc_rope, vc = keys_values(dc[..., -(MLA_KV_RANK + MLA_ROPE):-MLA_ROPE], dc[..., -MLA_ROPE:])
    kc = join(kc_nope, kc_rope)
    q = jnp.concatenate([q_nope, apply_rope(q_rope, cos, sin)], axis=-1)[:, :, :, None, :]
    k = join(k_nope, apply_rope(k_rope, cos, sin))
    o = sweep_attention(q, jnp.concatenate([kc, k], axis=1), jnp.concatenate([vc, v], axis=1))
    out_l = o.reshape(B, S, MLA_HEADS * MLA_V) @ w_o
    if not ctx_out:
        return out_l, None
    L = uc.shape[1]
    qc_nope, qc_rope = queries(dc[..., :MLA_Q_RANK])
    qc = jnp.concatenate([qc_nope, qc_rope], axis=-1)[:, :, :, None, :]
    oc = sweep_attention(qc, kc, vc)
    out_c = oc.reshape(B, L, MLA_HEADS * MLA_V) @ w_o
    return out_l, out_c


def setup_inputs(seed: int = 0) -> dict:
    key = jax.random.key(seed)
    k = jax.random.split(key, 26)
    n_even = (DEPTH + 1) // 2
    n_odd = DEPTH // 2
    f32 = jnp.float32

    def dense(kk, shape, fan_in, mult=1.0):
        return jax.random.normal(kk, shape, f32) * (mult * fan_in ** -0.5)

    def gain(kk, shape):
        return 1.0 + 0.02 * jax.random.normal(kk, shape, f32)

    return {
        "x": jax.random.normal(k[0], (BATCH, SEQ, D_MODEL), f32),
        "c": jax.random.normal(k[1], (BATCH, D_MODEL), f32),
        "ctx": jax.random.normal(k[2], (BATCH, CTX_LEN, D_MODEL), f32),
        "c_ctx": jax.random.normal(k[3], (D_MODEL,), f32),
        "norm_g": gain(k[4], (DEPTH, 3, D_MODEL)),
        "w_mod": dense(k[5], (DEPTH, D_MODEL, N_MOD * D_MODEL), D_MODEL, 0.5),
        "b_mod": 0.02 * jax.random.normal(k[6], (DEPTH, N_MOD * D_MODEL), f32),
        "ffn_w1": dense(k[7], (DEPTH, 2, D_MODEL, 2 * D_FF), D_MODEL),
        "ffn_w2": dense(k[8], (DEPTH, 2, D_FF, D_MODEL), D_FF),
        "ev_w_in": dense(k[9], (n_even, D_MODEL, EV_Q_COLS + EV_KV_COLS), D_MODEL),
        "ev_w_out": dense(k[10], (n_even, NA_WIDTH + GQA_Q_WIDTH, D_MODEL), NA_WIDTH + GQA_Q_WIDTH),
        "na_q_g": gain(k[11], (n_even, HEAD_DIM)),
        "na_k_g": gain(k[12], (n_even, HEAD_DIM)),
        "na_rpb": 0.1 * jax.random.normal(k[13], (n_even, NA_HEADS, 2 * NA_WIN_H - 1, 2 * NA_WIN_W - 1), f32),
        "gq_q_g": gain(k[14], (n_even, HEAD_DIM)),
        "gq_k_g": gain(k[15], (n_even, HEAD_DIM)),
        "mla_w_down": dense(k[16], (n_odd, D_MODEL, MLA_Q_RANK + MLA_KV_RANK + MLA_ROPE), D_MODEL),
        "mla_q_a_g": gain(k[17], (n_odd, MLA_Q_RANK)),
        "mla_kv_a_g": gain(k[18], (n_odd, MLA_KV_RANK)),
        "mla_w_uq": dense(k[19], (n_odd, MLA_Q_RANK, MLA_HEADS * (MLA_NOPE + MLA_ROPE)), MLA_Q_RANK),
        "mla_w_ukv": dense(k[20], (n_odd, MLA_KV_RANK, MLA_HEADS * (MLA_NOPE + MLA_V)), MLA_KV_RANK),
        "mla_qn_g": gain(k[21], (n_odd, MLA_NOPE)),
        "mla_qr_g": gain(k[22], (n_odd, MLA_ROPE)),
        "mla_kn_g": gain(k[23], (n_odd, MLA_NOPE)),
        "mla_kr_g": gain(k[24], (n_odd, MLA_ROPE)),
        "mla_w_o": dense(k[25], (n_odd, MLA_HEADS * MLA_V, D_MODEL), MLA_HEADS * MLA_V),
    }


def reference(x, c, ctx, c_ctx, norm_g, w_mod, b_mod, ffn_w1, ffn_w2, ev_w_in, ev_w_out, na_q_g, na_k_g,
              na_rpb, gq_q_g, gq_k_g, mla_w_down, mla_q_a_g, mla_kv_a_g, mla_w_uq, mla_w_ukv, mla_qn_g,
              mla_qr_g, mla_kn_g, mla_kr_g, mla_w_o):
    S = x.shape[1]
    cos_h, sin_h = axial_angles(S, HEAD_DIM)
    cos_r, sin_r = axial_angles(S, MLA_ROPE)
    hl, hc = x, ctx
    for i in range(DEPTH):
        last = i == DEPTH - 1
        ml = [m[:, None, :] for m in jnp.split(jax.nn.silu(c) @ w_mod[i] + b_mod[i], N_MOD, axis=-1)]
        mc = jnp.split(jax.nn.silu(c_ctx) @ w_mod[i] + b_mod[i], N_MOD, axis=-1)
        g = norm_g[i]
        hl = hl + 0.5 * ml[2] * swiglu(modulate(hl, g[0], ml[0], ml[1]), ffn_w1[i, 0], ffn_w2[i, 0])
        hc = hc + 0.5 * mc[2] * swiglu(modulate(hc, g[0], mc[0], mc[1]), ffn_w1[i, 0], ffn_w2[i, 0])
        ul = modulate(hl, g[1], ml[3], ml[4])
        uc = modulate(hc, g[1], mc[3], mc[4])
        j = i // 2
        if i % 2 == 0:
            ol, oc = even_mixer(ul, uc, ev_w_in[j], ev_w_out[j], na_q_g[j], na_k_g[j], na_rpb[j],
                                gq_q_g[j], gq_k_g[j], cos_h, sin_h, not last)
        else:
            ol, oc = mla_mixer(ul, uc, mla_w_down[j], mla_q_a_g[j], mla_kv_a_g[j], mla_w_uq[j], mla_w_ukv[j],
                               mla_qn_g[j], mla_qr_g[j], mla_kn_g[j], mla_kr_g[j], mla_w_o[j],
                               cos_r, sin_r, not last)
        hl = hl + ml[5] * ol
        hl = hl + 0.5 * ml[8] * swiglu(modulate(hl, g[2], ml[6], ml[7]), ffn_w1[i, 1], ffn_w2[i, 1])
        if not last:
            hc = hc + mc[5] * oc
            hc = hc + 0.5 * mc[8] * swiglu(modulate(hc, g[2], mc[6], mc[7]), ffn_w1[i, 1], ffn_w2[i, 1])
    return hl
```

```cpp
#include <hip/hip_runtime.h>
#include <cstdio>
#define DBG 0
#define ONE_LAUNCH 1
#include <cstdint>
#ifndef DBG
#define DBG 0
#endif
#ifndef ONE_LAUNCH
#define ONE_LAUNCH 1
#endif
#ifndef PG8_SP2
#define PG8_SP2 true
#endif
#ifndef PG8_ALIGN
#define PG8_ALIGN true
#endif
namespace pg8 {
#define PG8_LAS __attribute__((address_space(3)))
typedef unsigned short bf16_t;
typedef short bf16x8 __attribute__((ext_vector_type(8)));
typedef float f32x4 __attribute__((ext_vector_type(4)));
typedef unsigned u32x4 __attribute__((ext_vector_type(4)));
constexpr int BM = 256, BK = 64, HALF = 128, HTB = HALF * BK * 2  , STAGE_BYTES = 8 * HTB, NXCD = 8;
#ifndef PG8_WGM
#define PG8_WGM 8
#endif
constexpr int WGM = PG8_WGM;

__host__ __device__ __forceinline__ int lds_byte(int r, int c) { const int st = (r >> 4) * 2 + (c >> 5), rr = r & 15, cc = c & 31, ob = rr * 64 + cc * 2; return st * 1024 + (ob ^ (((ob >> 9) & 1) << 5)); }
__host__ __device__ __forceinline__ void stage_rc(int b, int& R, int& C) { const int st = b / 1024, sb = b % 1024, swz = sb ^ (((sb >> 9) & 1) << 5); R = (st >> 1) * 16 + swz / 64; C = (st & 1) * 32 + (swz % 64) / 2; }
__host__ __device__ __forceinline__ int perm32(int rho) { const int n = rho >> 4, i = rho & 15; return 8 * (i >> 2) + 4 * n + (i & 3); }

struct Unit { int pm, pn, k0, nt, sp, idx; };
struct Gemm { const bf16_t* A; const bf16_t* Bt; int M, N, K, lda, ldb; };

struct StaticOrder {
    int nM, nN, nwg, G, c, ntk, nmaj;
    __host__ __device__ void init(int M, int N, int G_, int c_, int K_, int nmaj_ = 0) { nM = M / BM; nN = N / BM; nwg = nM * nN; G = G_; c = c_; ntk = K_ / BK; nmaj = nmaj_; }
    __host__ __device__ __forceinline__ void map(int wgid, int& pm, int& pn) const {
        { const int q = nwg / NXCD, r = nwg % NXCD, xcd = wgid % NXCD, off = wgid / NXCD; wgid = (xcd < r ? xcd * (q + 1) : r * (q + 1) + (xcd - r) * q) + off; }
        if (nmaj > 0) { const int nig = nmaj * nM, gid = wgid / nig, fn = gid * nmaj, gsz = (nN - fn) < nmaj ? (nN - fn) : nmaj; pn = fn + ((wgid % nig) % gsz); pm = (wgid % nig) / gsz; return; }
        const int nig = WGM * nN, gid = wgid / nig, fm = gid * WGM, gsz = (nM - fm) < WGM ? (nM - fm) : WGM;
        pm = fm + ((wgid % nig) % gsz); pn = (wgid % nig) / gsz;
    }
    __host__ __device__ __forceinline__ bool next(int i, Unit& u) const {
        const long L = (long)i * G + c; if (L >= nwg) return false;
        int pm, pn; map((int)L, pm, pn); u.pm = pm; u.pn = pn; u.k0 = 0; u.nt = ntk; u.sp = -1; u.idx = i; return true;
    }
    __device__ __forceinline__ void a_ready(const Unit&) const {}
    __device__ __forceinline__ void done(const Unit&) const {}
};
__device__ __forceinline__ unsigned cvt_pk_bf16(float lo, float hi) { unsigned r; asm volatile("v_cvt_pk_bf16_f32 %0, %1, %2" : "=v"(r) : "v"(lo), "v"(hi)); return r; }
typedef float f32x2 __attribute__((ext_vector_type(2)));
template <class Epi, class Sched, bool ALIGN_EPI = false, bool SP2 = false>
__device__ __forceinline__ void gemm_phase(PG8_LAS unsigned char* lds, const Gemm g, const Sched& S, const Epi& E) {
    const int tid = threadIdx.x, wid = __builtin_amdgcn_readfirstlane(tid >> 6), lane = tid & 63, wr = wid >> 2, wc = wid & 3, fr = lane & 15, fq = lane >> 4;
    const int K = g.K;
    unsigned voffA[2], voffB[2];
#pragma unroll
    for (int i = 0; i < 2; ++i) { int R, C; stage_rc(tid * 16 + i * 8192, R, C); const int Rb = Epi::PERM ? ((R & ~31) + perm32(R & 31)) : R;
        voffA[i] = (unsigned)(R * g.lda + C) * 2u; voffB[i] = (unsigned)(Rb * (g.ldb ? g.ldb : BK) + C) * 2u; }
    const size_t kstepA = (size_t)(BK * 2), kstepB = g.ldb ? (size_t)(BK * 2) : (size_t)(BM * BK * 2);
    const size_t hstepA = (size_t)HALF * g.lda * 2, hstepB = g.ldb ? (size_t)HALF * g.ldb * 2 : (size_t)HALF * BK * 2;
    const size_t tstepA = 2 * hstepA, tstepB = g.ldb ? 2 * hstepB : (size_t)BM * K * 2;
    const unsigned ldsw = (unsigned)wid * 1024u;
    const int aoff = lds_byte(wr * 64 + fr, fq * 8), boff = lds_byte(wc * 32 + fr, fq * 8);
#define PG8_SA(b, h) (((b) * 2 + (h)) * HTB)
#define PG8_SB(b, h) ((4 + (b) * 2 + (h)) * HTB)
#define PG8_STAGE(bufoff, gbase, voff) do { _Pragma("unroll") for (int _i = 0; _i < 2; ++_i) \
        __builtin_amdgcn_global_load_lds((const unsigned*)((const char*)(gbase) + (voff)[_i]), (PG8_LAS unsigned*)(lds + (bufoff) + ldsw + _i * 8192), 16, 0, 0); } while (0)
#define PG8_LDA(dst, b, h) do { _Pragma("unroll") for (int m = 0; m < 4; ++m) _Pragma("unroll") for (int k = 0; k < 2; ++k) dst[m][k] = *(const PG8_LAS bf16x8*)(lds + PG8_SA(b, h) + aoff + m * 2048 + k * 1024); } while (0)
#define PG8_LDB(dst, b, h) do { _Pragma("unroll") for (int n = 0; n < 2; ++n) _Pragma("unroll") for (int k = 0; k < 2; ++k) dst[n][k] = *(const PG8_LAS bf16x8*)(lds + PG8_SB(b, h) + boff + n * 2048 + k * 1024); } while (0)
#define PG8_MMA(ai, bj, At, Bt) do { __builtin_amdgcn_s_setprio(1); _Pragma("unroll") for (int m = 0; m < 4; ++m) _Pragma("unroll") for (int n = 0; n < 2; ++n) _Pragma("unroll") for (int k = 0; k < 2; ++k) \
        acc[ai][bj][m][n] = __builtin_amdgcn_mfma_f32_16x16x32_bf16(Bt[n][k], At[m][k], acc[ai][bj][m][n], 0, 0, 0); __builtin_amdgcn_s_setprio(0); } while (0)
#define PG8_WAIT_V(n) asm volatile("s_waitcnt vmcnt(" #n ")" ::: "memory")
#define PG8_WAIT_L(n) asm volatile("s_waitcnt lgkmcnt(" #n ")" ::: "memory")
#define PG8_BAR __builtin_amdgcn_s_barrier()
#define PG8_SCHED __builtin_amdgcn_sched_barrier(0)
    Unit cur, nxt; int ui = 0;
    if (!S.next(0, cur)) return;
    f32x4 acc[2][2][4][2];
#pragma unroll
    for (int a = 0; a < 2; ++a)
#pragma unroll
        for (int b = 0; b < 2; ++b)
#pragma unroll
            for (int m = 0; m < 4; ++m)
#pragma unroll
                for (int n = 0; n < 2; ++n) acc[a][b][m][n] = (f32x4){0.f, 0.f, 0.f, 0.f};
    bf16x8 At[4][2], B0[2][2], B1[2][2];
    const char* cA = (const char*)g.A + (size_t)cur.pm * tstepA + (size_t)cur.k0 * kstepA; const char* cB = (const char*)g.Bt + (size_t)cur.pn * tstepB + (size_t)cur.k0 * kstepB;
    S.a_ready(cur);
    if constexpr (SP2) {
        PG8_STAGE(PG8_SB(0, 0), cB, voffB); PG8_STAGE(PG8_SB(0, 1), cB + hstepB, voffB); PG8_STAGE(PG8_SA(0, 0), cA, voffA); PG8_STAGE(PG8_SA(0, 1), cA + hstepA, voffA);
        if (wr == 1) PG8_BAR;
        PG8_WAIT_V(2); PG8_BAR;
        PG8_STAGE(PG8_SB(1, 0), cB + kstepB, voffB); PG8_STAGE(PG8_SA(1, 0), cA + kstepA, voffA); PG8_STAGE(PG8_SB(1, 1), cB + hstepB + kstepB, voffB);
        PG8_WAIT_V(6); PG8_BAR;
    } else {
        PG8_STAGE(PG8_SB(0, 0), cB, voffB); PG8_STAGE(PG8_SA(0, 0), cA, voffA); PG8_STAGE(PG8_SB(0, 1), cB + hstepB, voffB); PG8_STAGE(PG8_SA(0, 1), cA + hstepA, voffA);
        if (wr == 1) PG8_BAR;
        PG8_WAIT_V(4); PG8_BAR;
        PG8_STAGE(PG8_SB(1, 0), cB + kstepB, voffB); PG8_STAGE(PG8_SA(1, 0), cA + kstepA, voffA); PG8_STAGE(PG8_SB(1, 1), cB + hstepB + kstepB, voffB);
        PG8_WAIT_V(6); PG8_BAR;
    }
    for (;;) {
        const bool has_next = S.next(ui + 1, nxt);
        const char* nA = has_next ? (const char*)g.A + (size_t)nxt.pm * tstepA + (size_t)nxt.k0 * kstepA : cA; const char* nB = has_next ? (const char*)g.Bt + (size_t)nxt.pn * tstepB + (size_t)nxt.k0 * kstepB : cB;
        const int nt = cur.nt;
        for (int t = 0; t < nt; t += 2) {
            const bool last = (t == nt - 2);
            const char* a1 = cA + (size_t)(t + 1) * kstepA;
            const char* a2 = last ? nA : cA + (size_t)(t + 2) * kstepA; const char* b2 = last ? nB : cB + (size_t)(t + 2) * kstepB;
            const char* a3 = a2 + kstepA; const char* b3 = b2 + kstepB;
            if (last && has_next) S.a_ready(nxt);
            if constexpr (SP2) {
            PG8_LDB(B0, 0, 0); PG8_LDB(B1, 0, 1); PG8_SCHED; PG8_LDA(At, 0, 0); PG8_STAGE(PG8_SA(1, 1), a1 + hstepA, voffA);
            PG8_WAIT_V(8); PG8_WAIT_L(0); PG8_BAR; PG8_MMA(0, 0, At, B0); PG8_MMA(0, 1, At, B1); PG8_BAR; PG8_SCHED;
            PG8_LDA(At, 0, 1); PG8_STAGE(PG8_SB(0, 0), b2, voffB); PG8_STAGE(PG8_SB(0, 1), b2 + hstepB, voffB); PG8_STAGE(PG8_SA(0, 0), a2, voffA);
            PG8_WAIT_V(8); PG8_WAIT_L(0); PG8_BAR; PG8_MMA(1, 0, At, B0); PG8_MMA(1, 1, At, B1); PG8_BAR; PG8_SCHED;
            PG8_LDB(B0, 1, 0); PG8_LDB(B1, 1, 1); PG8_SCHED; PG8_LDA(At, 1, 0); PG8_STAGE(PG8_SA(0, 1), a2 + hstepA, voffA);
            PG8_WAIT_V(8); PG8_WAIT_L(0); PG8_BAR; PG8_MMA(0, 0, At, B0); PG8_MMA(0, 1, At, B1); PG8_BAR; PG8_SCHED;
            PG8_LDA(At, 1, 1); PG8_STAGE(PG8_SB(1, 0), b3, voffB); PG8_STAGE(PG8_SB(1, 1), b3 + hstepB, voffB); PG8_STAGE(PG8_SA(1, 0), a3, voffA);
            PG8_WAIT_V(8); PG8_WAIT_L(0); PG8_BAR; PG8_MMA(1, 0, At, B0); PG8_MMA(1, 1, At, B1); PG8_BAR; PG8_SCHED;
            } else {
            PG8_LDB(B0, 0, 0); PG8_SCHED; PG8_LDA(At, 0, 0); PG8_STAGE(PG8_SA(1, 1), a1 + hstepA, voffA);
            PG8_WAIT_L(8); PG8_BAR; PG8_WAIT_L(0); PG8_MMA(0, 0, At, B0); PG8_BAR; PG8_SCHED;
            PG8_LDB(B1, 0, 1); PG8_STAGE(PG8_SB(0, 0), b2, voffB);
            PG8_BAR; PG8_WAIT_L(0); PG8_MMA(0, 1, At, B1); PG8_BAR;
            PG8_LDA(At, 0, 1); PG8_STAGE(PG8_SA(0, 0), a2, voffA);
            PG8_BAR; PG8_WAIT_L(0); PG8_MMA(1, 0, At, B0); PG8_BAR; PG8_SCHED;
            PG8_STAGE(PG8_SB(0, 1), b2 + hstepB, voffB);
            PG8_WAIT_V(6); PG8_BAR; PG8_MMA(1, 1, At, B1); PG8_BAR;
            PG8_LDB(B0, 1, 0); PG8_SCHED; PG8_LDA(At, 1, 0); PG8_STAGE(PG8_SA(0, 1), a2 + hstepA, voffA);
            PG8_WAIT_L(8); PG8_BAR; PG8_WAIT_L(0); PG8_MMA(0, 0, At, B0); PG8_BAR; PG8_SCHED;
            PG8_LDB(B1, 1, 1); PG8_STAGE(PG8_SB(1, 0), b3, voffB);
            PG8_BAR; PG8_WAIT_L(0); PG8_MMA(0, 1, At, B1); PG8_BAR;
            PG8_LDA(At, 1, 1); PG8_STAGE(PG8_SA(1, 0), a3, voffA);
            PG8_BAR; PG8_WAIT_L(0); PG8_MMA(1, 0, At, B0); PG8_BAR; PG8_SCHED;
            PG8_STAGE(PG8_SB(1, 1), b3 + hstepB, voffB);
            PG8_WAIT_V(6); PG8_BAR; PG8_MMA(1, 1, At, B1); PG8_BAR;
            }
        }
        if constexpr (ALIGN_EPI) { if (wr == 0) PG8_BAR; }
        if constexpr (!Epi::AFTER_DRAIN) { E(acc, cur, wr, wc, fr, fq); S.done(cur); }
        if (!has_next) break;
#pragma unroll
        for (int a = 0; a < 2; ++a)
#pragma unroll
            for (int b = 0; b < 2; ++b)
#pragma unroll
                for (int m = 0; m < 4; ++m)
#pragma unroll
                    for (int n = 0; n < 2; ++n) acc[a][b][m][n] = (f32x4){0.f, 0.f, 0.f, 0.f};
        cur = nxt; cA = nA; cB = nB; ++ui;
        if constexpr (ALIGN_EPI) { if (wr == 1) PG8_BAR; }
    }
    PG8_WAIT_V(0);
    if constexpr (!ALIGN_EPI) { if (wr == 0) PG8_BAR; }
    PG8_BAR;
    if constexpr (Epi::AFTER_DRAIN) { E.fused(acc, cur, wr, wc, fr, fq, lds, wid, lane); S.done(cur); }
#undef PG8_SA
#undef PG8_SB
#undef PG8_STAGE
#undef PG8_LDA
#undef PG8_LDB
#undef PG8_MMA
#undef PG8_WAIT_V
#undef PG8_WAIT_L
#undef PG8_BAR
#undef PG8_SCHED
}
struct EpiBf16P {
    static constexpr bool PERM = true, AFTER_DRAIN = false;
    bf16_t* O; int ldc;
    __device__ __forceinline__ void operator()(const f32x4 (&acc)[2][2][4][2], const Unit& u, int wr, int wc, int fr, int fq) const {
        const int row0 = u.pm * BM + wr * 64 + fr, col0 = u.pn * BM + wc * 32 + 8 * fq;
#pragma unroll
        for (int ai = 0; ai < 2; ++ai)
#pragma unroll
            for (int m = 0; m < 4; ++m) { bf16_t* rowp = O + (size_t)(row0 + ai * HALF + m * 16) * ldc + col0;
#pragma unroll
                for (int bj = 0; bj < 2; ++bj) { const f32x4 v0 = acc[ai][bj][m][0], v1 = acc[ai][bj][m][1];
                    u32x4 w; w.x = cvt_pk_bf16(v0[0], v0[1]); w.y = cvt_pk_bf16(v0[2], v0[3]); w.z = cvt_pk_bf16(v1[0], v1[1]); w.w = cvt_pk_bf16(v1[2], v1[3]);
                    *(u32x4*)(rowp + bj * HALF) = w; } }
    }
};
struct EpiF32P {
    static constexpr bool PERM = false, AFTER_DRAIN = false;
    float* C; int ldc;
    __device__ __forceinline__ void operator()(const f32x4 (&acc)[2][2][4][2], const Unit& u, int wr, int wc, int fr, int fq) const {
        const int row0 = u.pm * BM + wr * 64 + fr, col0 = u.pn * BM + wc * 32 + 4 * fq;
#pragma unroll
        for (int ai = 0; ai < 2; ++ai)
#pragma unroll
            for (int m = 0; m < 4; ++m) { float* rowp = C + (size_t)(row0 + ai * HALF + m * 16) * ldc + col0;
#pragma unroll
                for (int bj = 0; bj < 2; ++bj)
#pragma unroll
                    for (int n = 0; n < 2; ++n) *(f32x4*)(rowp + bj * HALF + n * 16) = acc[ai][bj][m][n]; }
    }
};
__device__ __forceinline__ float silu_mul(float g, float u) { const float e = __builtin_amdgcn_exp2f(g * -1.4426950408889634f); return g * __builtin_amdgcn_rcpf(1.0f + e) * u; }
struct EpiSwiglu {
    static constexpr bool PERM = true, AFTER_DRAIN = false;
    bf16_t* O; int ldc;
    __device__ __forceinline__ void operator()(const f32x4 (&acc)[2][2][4][2], const Unit& u, int wr, int wc, int fr, int fq) const {
        const int row0 = u.pm * BM + wr * 64 + fr, col0 = u.pn * HALF + wc * 32 + 8 * fq;
#pragma unroll
        for (int ai = 0; ai < 2; ++ai)
#pragma unroll
            for (int m = 0; m < 4; ++m) { bf16_t* rowp = O + (size_t)(row0 + ai * HALF + m * 16) * ldc + col0;
                const f32x4 g0 = acc[ai][0][m][0], g1 = acc[ai][0][m][1], u0 = acc[ai][1][m][0], u1 = acc[ai][1][m][1];
                u32x4 w; w.x = cvt_pk_bf16(silu_mul(g0[0], u0[0]), silu_mul(g0[1], u0[1])); w.y = cvt_pk_bf16(silu_mul(g0[2], u0[2]), silu_mul(g0[3], u0[3]));
                w.z = cvt_pk_bf16(silu_mul(g1[0], u1[0]), silu_mul(g1[1], u1[1])); w.w = cvt_pk_bf16(silu_mul(g1[2], u1[2]), silu_mul(g1[3], u1[3]));
                *(u32x4*)rowp = w; }
    }
};
struct EpiResid {
    static constexpr bool PERM = false, AFTER_DRAIN = false;
    const float* res_lat; const float* res_ctx; float* out; const float* gate; float gs;
    __device__ __forceinline__ void operator()(const f32x4 (&acc)[2][2][4][2], const Unit& u, int wr, int wc, int fr, int fq) const {
        const int rt = wr * 64 + fr, col0 = u.pn * BM + wc * 32 + 4 * fq;
        const int vec = u.pm < 16 ? 0 : (u.pm < 32 ? 1 : 2);
        const float* rbase = (u.pm < 32 ? res_lat + (size_t)u.pm * BM * 4096 : res_ctx + (size_t)(u.pm - 32) * BM * 4096) + col0;
        float* obase = out + (size_t)u.pm * BM * 4096 + col0;
        const float* gp = gate + (size_t)vec * 9 * 4096 + col0;
        f32x4 gv[2][2];
#pragma unroll
        for (int bj = 0; bj < 2; ++bj)
#pragma unroll
            for (int n = 0; n < 2; ++n) gv[bj][n] = *(const f32x4*)(gp + bj * HALF + n * 16) * gs;
#pragma unroll
        for (int ai = 0; ai < 2; ++ai)
#pragma unroll
            for (int m = 0; m < 4; ++m) { const size_t ro = (size_t)(rt + ai * HALF + m * 16) * 4096;
#pragma unroll
                for (int bj = 0; bj < 2; ++bj)
#pragma unroll
                    for (int n = 0; n < 2; ++n) { const f32x4 r = *(const f32x4*)(rbase + ro + bj * HALF + n * 16);
                        *(f32x4*)(obase + ro + bj * HALF + n * 16) = r + gv[bj][n] * acc[ai][bj][m][n]; }
                asm volatile("" ::: "memory"); }
    }
};

struct SplitOrder {
    StaticOrder lat; int G, c, ntk;
    __host__ __device__ void init(int G_, int c_, int K_) { lat.init(8192, 4096, G_, c_, K_); G = G_; c = c_; ntk = K_ / BK; }
    __host__ __device__ __forceinline__ bool next(int i, Unit& u) const {
        const long L = (long)i * G + c; if (L >= 768) return false;
        const bool isl = L < 512; int pm, pn; lat.map(isl ? (int)L : 0, pm, pn);
        const int j = (int)(L - 512) & 255, sp = j & 7, tile = j >> 3, ntq = ntk / 8;
        u.pm = isl ? pm : 32 + (tile >> 4); u.pn = isl ? pn : (tile & 15); u.k0 = isl ? 0 : sp * ntq; u.nt = isl ? ntk : ntq; u.sp = isl ? -1 : sp; u.idx = i; return true;
    }
    __device__ __forceinline__ void a_ready(const Unit&) const {}
    __device__ __forceinline__ void done(const Unit&) const {}
};
struct EpiResidSplit {
    static constexpr bool PERM = false, AFTER_DRAIN = false;
    EpiResid r; float* slab;
    __device__ __forceinline__ void operator()(const f32x4 (&acc)[2][2][4][2], const Unit& u, int wr, int wc, int fr, int fq) const {
        if (u.sp < 0) { r(acc, u, wr, wc, fr, fq); return; }
        const int row0 = (u.pm - 32) * BM + wr * 64 + fr, col0 = u.pn * BM + wc * 32 + 4 * fq;
        float* base = slab + ((size_t)u.sp * 512 + row0) * 4096 + col0;
#pragma unroll
        for (int ai = 0; ai < 2; ++ai)
#pragma unroll
            for (int m = 0; m < 4; ++m) { float* rowp = base + (size_t)(ai * HALF + m * 16) * 4096;
#pragma unroll
                for (int bj = 0; bj < 2; ++bj)
#pragma unroll
                    for (int n = 0; n < 2; ++n) *(f32x4*)(rowp + bj * HALF + n * 16) = acc[ai][bj][m][n]; }
    }
};

}
namespace att {
#define ATT_LAS __attribute__((address_space(3)))
typedef unsigned short bf16;
using bf16x8 = __attribute__((ext_vector_type(8))) short;
using s16x4  = __attribute__((ext_vector_type(4))) short;
using f32x16 = __attribute__((ext_vector_type(16))) float;
using u32x4  = __attribute__((ext_vector_type(4))) unsigned;
constexpr int NW = 8, QBLK = 32, KVBLK = 64, DV = 128;
constexpr float THR = 8.f;
#define ATT_SBAR() __builtin_amdgcn_sched_barrier(0)
__device__ __forceinline__ int crow(int r, int hi) { return (r & 3) + 8 * (r >> 2) + 4 * hi; }
__device__ __forceinline__ unsigned cvtpk(float lo, float hi) { unsigned r; asm volatile("v_cvt_pk_bf16_f32 %0, %1, %2" : "=v"(r) : "v"(lo), "v"(hi)); return r; }
typedef unsigned rawx4 __attribute__((ext_vector_type(4)));
__device__ __forceinline__ __amdgpu_buffer_rsrc_t mk_rsrc(const void* p) {
  const unsigned long long a = (unsigned long long)p; const unsigned lo = __builtin_amdgcn_readfirstlane((unsigned)a), hi = __builtin_amdgcn_readfirstlane((unsigned)(a >> 32));
  return __builtin_amdgcn_make_buffer_rsrc((void*)(((unsigned long long)hi << 32) | lo), 0, 0x7ffffffc, 0x00020000);
}
__device__ __forceinline__ bf16x8 ld16(__amdgpu_buffer_rsrc_t r, int voff, int soff) { const rawx4 v = __builtin_amdgcn_raw_buffer_load_b128(r, voff, soff, 0); return *reinterpret_cast<const bf16x8*>(&v); }
template <int DK> __device__ __forceinline__ int kswz(int row) { return DK == 192 ? ((row >> 1) & 7) : (row & 7); }
template <int DK> struct Cfg { static constexpr float SCALE = DK == 128 ? 0.088388347648318440f : 0.072168783648703220f;
    static constexpr int SHM_V = KVBLK * DV * 2, SHM_K = KVBLK * DK * 2, SHM_WS = 2 * SHM_V + 2 * SHM_K, SHM_RPB = SHM_WS + NW * 64 * 4, SHM_QR = SHM_RPB + 2048, SHM_END = SHM_QR;
    static constexpr int NQR = DK / 16;
    static constexpr int NKP = DK / 64;     static constexpr int SDEPTH = DK == 128 ? 2 : 1; };

template <int DK> __device__ __forceinline__ void partialSM(f32x16& p0, f32x16& p1, float& m_reg, float& mn, float& alpha) {
  constexpr float SCALE = Cfg<DK>::SCALE, C = SCALE * 1.4426950408889634f;
  float pmax = p0[0];
#pragma unroll
  for (int r = 1; r < 16; ++r) pmax = fmaxf(pmax, p0[r]);
#pragma unroll
  for (int r = 0; r < 16; ++r) pmax = fmaxf(pmax, p1[r]);
  { auto rr = __builtin_amdgcn_permlane32_swap(__float_as_uint(pmax), __float_as_uint(pmax), false, false);
    pmax = fmaxf(__uint_as_float(rr[0]), __uint_as_float(rr[1])); }
  if (__builtin_expect(__all(pmax - m_reg <= THR / SCALE), 1)) { mn = m_reg; alpha = 1.f; }
  else { mn = fmaxf(m_reg, pmax); alpha = __builtin_amdgcn_exp2f((m_reg - mn) * C); m_reg = mn; }
  const float mnC = -mn * C;
#pragma unroll
  for (int r = 0; r < 16; ++r) p0[r] = fmaf(p0[r], C, mnC);
#pragma unroll
  for (int r = 0; r < 16; ++r) p1[r] = fmaf(p1[r], C, mnC);
#pragma unroll
  for (int r = 0; r < 16; ++r) p0[r] = __builtin_amdgcn_exp2f(p0[r]);
}
__device__ __forceinline__ void finishSM(f32x16& p0, f32x16& p1, float alpha, float& l_reg, bf16x8& pa0, bf16x8& pa1, bf16x8& pa2, bf16x8& pa3) {
#pragma unroll
  for (int r = 0; r < 16; ++r) p1[r] = __builtin_amdgcn_exp2f(p1[r]);
  float ps = 0;
#pragma unroll
  for (int r = 0; r < 16; ++r) ps += p0[r];
#pragma unroll
  for (int r = 0; r < 16; ++r) ps += p1[r];
  { auto rr = __builtin_amdgcn_permlane32_swap(__float_as_uint(ps), __float_as_uint(ps), false, false);
    ps = __uint_as_float(rr[0]) + __uint_as_float(rr[1]); }
  l_reg = l_reg * alpha + ps;
#define ATT_PK4(P, BASE, OUT) do { unsigned a0 = cvtpk(P[BASE + 0], P[BASE + 1]), a1 = cvtpk(P[BASE + 2], P[BASE + 3]);   \
    unsigned b0 = cvtpk(P[BASE + 4], P[BASE + 5]), b1 = cvtpk(P[BASE + 6], P[BASE + 7]);                              \
    auto r0 = __builtin_amdgcn_permlane32_swap(a0, b0, false, false); auto r1 = __builtin_amdgcn_permlane32_swap(a1, b1, false, false); \
    u32x4 w = {r0[0], r1[0], r0[1], r1[1]}; OUT = *reinterpret_cast<bf16x8*>(&w); } while (0)
  ATT_PK4(p0, 0, pa0); ATT_PK4(p0, 8, pa1); ATT_PK4(p1, 0, pa2); ATT_PK4(p1, 8, pa3);
#undef ATT_PK4
}
struct NaWave { int na;
                int r0w;
                int rq;
                int cq, c0;
                int rlo;
                const ATT_LAS float* rpb; };
template <int DK, bool NA> __device__ __forceinline__ void qkt(f32x16& p0, f32x16& p1, const char* Ks, const bf16x8* qr, const char* qlds, const int (&kx)[4], int hi, const NaWave& nw, int tile) {
  p0 = f32x16{}; p1 = f32x16{};
  if constexpr (NA) {
    if (nw.na && tile >= 4) {
      const int kr = nw.rlo + (tile - 4);
      if (kr >= nw.r0w && kr < nw.r0w + 8) {
        const int base = (kr - nw.rq + 7) * 31 - nw.cq + 15;
#pragma unroll
        for (int r = 0; r < 16; ++r) { const int ck = crow(r, hi); const bool ok0 = (unsigned)(ck - nw.c0) < 16u, ok1 = (unsigned)(ck + 32 - nw.c0) < 16u;
          const float b0 = nw.rpb[ok0 ? base + ck : 0], b1 = nw.rpb[ok1 ? base + ck + 32 : 0];
          p0[r] = ok0 ? b0 : -1e30f; p1[r] = ok1 ? b1 : -1e30f; }
      } else {
#pragma unroll
        for (int r = 0; r < 16; ++r) { p0[r] = -1e30f; p1[r] = -1e30f; }
      }
    }
  }
#pragma unroll
  for (int d0 = 0; d0 < DK / 16; ++d0) {
    const bf16x8 b0 = *reinterpret_cast<const bf16x8*>(Ks + kx[d0 & 3] + (d0 >> 2) * 128);
    const bf16x8 b1 = *reinterpret_cast<const bf16x8*>(Ks + kx[d0 & 3] + (d0 >> 2) * 128 + 32 * (DK * 2));
    bf16x8 qf; if (d0 < Cfg<DK>::NQR) qf = qr[d0 < Cfg<DK>::NQR ? d0 : 0]; else qf = *reinterpret_cast<const bf16x8*>(qlds + (d0 - Cfg<DK>::NQR) * 1024);
    p0 = __builtin_amdgcn_mfma_f32_32x32x16_bf16(b0, qf, p0, 0, 0, 0);
    p1 = __builtin_amdgcn_mfma_f32_32x32x16_bf16(b1, qf, p1, 0, 0, 0); }
}
__device__ __forceinline__ int v_st(int k, int c) { const int kk = (k & ~0xC) | ((k & 4) << 1) | ((k & 8) >> 1); return ((kk >> 3) * 4 + (c >> 5)) * 512 + ((kk & 7) * 32 + (c & 31)) * 2; }
__device__ __forceinline__ int v_rd_base(int lane) { return ((lane & 3) << 3) | (((lane >> 2) & 3) << 6) | (((lane >> 4) & 1) << 5) | (((lane >> 5) & 1) << 8); }
constexpr int v_rd_off(int d0, int ks, int half) { return d0 * 512 + ks * 4096 + half * 2048; }
template <int OFF> __device__ __forceinline__ s16x4 tr_read(int vb) {
  s16x4 r; asm volatile("ds_read_b64_tr_b16 %0, %1 offset:%2" : "=&v"(r) : "v"(vb), "i"(OFF) : "memory"); return r;
}
template <int D0> __device__ __forceinline__ void pv_one(f32x16& od, int vb, bf16x8 pa0, bf16x8 pa1, bf16x8 pa2, bf16x8 pa3) {
  const s16x4 l0 = tr_read<v_rd_off(D0, 0, 0)>(vb), h0 = tr_read<v_rd_off(D0, 0, 1)>(vb), l1 = tr_read<v_rd_off(D0, 1, 0)>(vb), h1 = tr_read<v_rd_off(D0, 1, 1)>(vb);
  const s16x4 l2 = tr_read<v_rd_off(D0, 2, 0)>(vb), h2 = tr_read<v_rd_off(D0, 2, 1)>(vb), l3 = tr_read<v_rd_off(D0, 3, 0)>(vb), h3 = tr_read<v_rd_off(D0, 3, 1)>(vb);
  asm volatile("s_waitcnt lgkmcnt(0)" ::: "memory"); ATT_SBAR();
#define ATT_PK(L, H) (bf16x8){L[0], L[1], L[2], L[3], H[0], H[1], H[2], H[3]}
  od = __builtin_amdgcn_mfma_f32_32x32x16_bf16(pa0, ATT_PK(l0, h0), od, 0, 0, 0);
  od = __builtin_amdgcn_mfma_f32_32x32x16_bf16(pa1, ATT_PK(l1, h1), od, 0, 0, 0);
  od = __builtin_amdgcn_mfma_f32_32x32x16_bf16(pa2, ATT_PK(l2, h2), od, 0, 0, 0);
  od = __builtin_amdgcn_mfma_f32_32x32x16_bf16(pa3, ATT_PK(l3, h3), od, 0, 0, 0);
#undef ATT_PK
}
__device__ __forceinline__ void pv_d0(f32x16* o, int vb, bf16x8 pa0, bf16x8 pa1, bf16x8 pa2, bf16x8 pa3) {
  pv_one<0>(o[0], vb, pa0, pa1, pa2, pa3); pv_one<1>(o[1], vb, pa0, pa1, pa2, pa3); pv_one<2>(o[2], vb, pa0, pa1, pa2, pa3); pv_one<3>(o[3], vb, pa0, pa1, pa2, pa3);
}

template <int DK, bool NA>
__device__ __forceinline__ void attn_body(const bf16* __restrict__ Qb, int ldq, const bf16* __restrict__ Kh, int ldk, const bf16* __restrict__ Vh, int ldv,
                                          bf16* __restrict__ Ob, int ldo, int NT, int seg2, const NaWave& nw, char* lds) {
  using C_ = Cfg<DK>; constexpr int SHM_V = C_::SHM_V, SHM_K = C_::SHM_K, NKP = C_::NKP;
  int tid = threadIdx.x; asm volatile("" : "+v"(tid));
  const int wid = tid >> 6, lane = tid & 63, r32 = lane & 31, hi = lane >> 5;
  char* V_lds = lds; char* K_lds = lds + 2 * SHM_V;
  float* wsf = (float*)(lds + C_::SHM_WS) + wid * 64; float* li_l = wsf; float* al_l = wsf + 32;
  float m_reg = -1e30f, l_reg = 0; f32x16 o[4] = {}; bf16x8 qr[C_::NQR]; char* qlds = nullptr;
  __syncthreads();
  const bf16* Qw = Qb + (long)(wid * QBLK + r32) * ldq + hi * 8;
#pragma unroll
  for (int d0 = 0; d0 < DK / 16; ++d0) { const bf16x8 qv = *reinterpret_cast<const bf16x8*>(Qw + d0 * 16); if (d0 < C_::NQR) qr[d0 < C_::NQR ? d0 : 0] = qv; else *reinterpret_cast<bf16x8*>(qlds + (d0 - C_::NQR) * 1024) = qv; }
  const int sr = tid >> 4, sc = (tid & 15) * 8, vst0 = v_st(sr, sc), vst1 = vst0 + 8192;
  const __amdgpu_buffer_rsrc_t krs = mk_rsrc(Kh), vrs = mk_rsrc(Vh); const int vgo0 = (sr * ldv + sc) * 2, ldk2 = __builtin_amdgcn_readfirstlane(ldk * 2), ldv2 = __builtin_amdgcn_readfirstlane(ldv * 2);
  const int kgo0 = ((tid >> 3) * ldk + (tid & 7) * 8) * 2, klo0 = (tid >> 3) * (DK * 2) + (((tid & 7) * 16) ^ (kswz<DK>(tid >> 3) << 4));
  const int vb0 = (int)(uintptr_t)V_lds + v_rd_base(lane);
  int kx[4];
#pragma unroll
  for (int dl = 0; dl < 4; ++dl) kx[dl] = r32 * (DK * 2) + ((dl * 32 + hi * 16) ^ (kswz<DK>(r32) << 4));
  bf16x8 vs0, vs1, ks[NKP];
#define ATT_KOFF(t) ((t) * KVBLK + ((NA && (t) >= 4) ? seg2 : 0))
#define ATT_SLOAD(t) do { const int k0_ = __builtin_amdgcn_readfirstlane(ATT_KOFF(t)); vs0 = ld16(vrs, vgo0, k0_ * ldv2); vs1 = ld16(vrs, vgo0, (k0_ + 32) * ldv2); \
    _Pragma("unroll") for (int q_ = 0; q_ < NKP; ++q_) ks[q_] = ld16(krs, kgo0 + 128 * q_, k0_ * ldk2); } while (0)
#define ATT_SWRITE(b) do { *(bf16x8*)(V_lds + (b) * SHM_V + vst0) = vs0; *(bf16x8*)(V_lds + (b) * SHM_V + vst1) = vs1; \
    _Pragma("unroll") for (int q_ = 0; q_ < NKP; ++q_) *(bf16x8*)(K_lds + (b) * SHM_K + klo0 + 128 * q_) = ks[q_]; } while (0)
  ATT_SLOAD(0); asm volatile("s_waitcnt vmcnt(0)" ::: "memory"); ATT_SWRITE(0); __syncthreads();
  for (int t = 0; t < NT; ++t) {
    const int b = t & 1;
    if (t + 1 < NT) ATT_SLOAD(t + 1);
    f32x16 p0, p1; float mn, alpha; bf16x8 pa0, pa1, pa2, pa3;
    qkt<DK, NA>(p0, p1, K_lds + b * SHM_K, qr, qlds, kx, hi, nw, t);
    partialSM<DK>(p0, p1, m_reg, mn, alpha);
    finishSM(p0, p1, alpha, l_reg, pa0, pa1, pa2, pa3);
    if (__any(alpha < 1.f)) { if (hi == 0) al_l[r32] = alpha; asm volatile("s_waitcnt lgkmcnt(0)" ::: "memory");
#pragma unroll
      for (int d = 0; d < 4; ++d)
#pragma unroll
        for (int r = 0; r < 16; ++r) o[d][r] *= al_l[crow(r, hi)]; }
    ATT_SBAR();
    pv_d0(o, vb0 + b * SHM_V, pa0, pa1, pa2, pa3);
    if (t + 1 < NT) { asm volatile("s_waitcnt vmcnt(0)" ::: "memory"); ATT_SWRITE(b ^ 1); }
    __syncthreads();
  }
  if (hi == 0) li_l[r32] = l_reg; asm volatile("s_waitcnt lgkmcnt(0)" ::: "memory");
  float rli[16];
#pragma unroll
  for (int r = 0; r < 16; ++r) rli[r] = __builtin_amdgcn_rcpf(li_l[crow(r, hi)]);
  bf16* Ow = Ob + (long)(wid * QBLK) * ldo;
#pragma unroll
  for (int r = 0; r < 16; ++r) { const int orow = crow(r, hi);
#pragma unroll
    for (int d0 = 0; d0 < 4; ++d0) Ow[(long)orow * ldo + d0 * 32 + r32] = (bf16)(cvtpk(o[d0][r] * rli[r], 0.f) & 0xffffu); }
#undef ATT_KOFF
#undef ATT_SLOAD
#undef ATT_SWRITE
}

}
#define GAS __attribute__((address_space(1)))
#define LAS __attribute__((address_space(3)))
typedef unsigned short bf16;
typedef unsigned v4u __attribute__((ext_vector_type(4)));
typedef unsigned v2u __attribute__((ext_vector_type(2)));
typedef float f32x4 __attribute__((ext_vector_type(4)));
typedef short bf16x8 __attribute__((ext_vector_type(8)));
constexpr int NWAVES = 8;
constexpr int DM = 4096, SEQ = 4096, CTXL = 256, DFF = 10240, NLAT = 8192, NCTXR = 512, MROWS = 8704, NKEY = 4352, NMOD = 9;
constexpr int EVN = 9216, DLN = 1792, UQN = 6144, UKVN = 8192;
constexpr float EPS = 1e-6f;
constexpr size_t MiB = 1u << 20;
constexpr size_t WS_CTL = 0, CTL_ZERO_BYTES = 1 * MiB;
constexpr size_t WS_MOD = 1 * MiB;
constexpr size_t WS_WT1 = 2 * MiB, WT1_SZ = 160 * MiB;
constexpr size_t WS_WT2 = 642 * MiB, WT2_SZ = 80 * MiB;
constexpr size_t WS_WIN = 962 * MiB, WS_WOUT = 1034 * MiB, WS_WDOWN = 1066 * MiB, WS_WUQ = 1080 * MiB, WS_WUKV = 1092 * MiB, WS_WO = 1100 * MiB;
constexpr size_t WS_HA = 1132 * MiB, WS_HB = 1268 * MiB;
constexpr size_t WS_U = 1404 * MiB;
constexpr size_t WS_HID = 1472 * MiB;
constexpr size_t WS_AO = 1642 * MiB;
constexpr size_t WS_P = 1710 * MiB;
constexpr size_t WS_QB = 1863 * MiB;
constexpr size_t WS_KN = 1931 * MiB, WS_VN = 1965 * MiB;
constexpr size_t WS_KG = 1999 * MiB, WS_VG = 2008 * MiB;
constexpr size_t WS_DL = 2017 * MiB;
constexpr size_t WS_CQN = 2077 * MiB, WS_CKVN = 2094 * MiB, WS_KR = 2103 * MiB;
constexpr size_t WS_QRAW = 2105 * MiB, WS_KVRAW = 2201 * MiB;
constexpr size_t WS_QM = 2337 * MiB, WS_KM = 2433 * MiB, WS_VM = 2535 * MiB;
constexpr size_t WS_SLAB = 2603 * MiB;
constexpr size_t WS_DBG = 2667 * MiB;
constexpr size_t WS_END = 2668 * MiB;
constexpr int CW_BAR = 4096;
constexpr int RING_BYTES = 131072, LDS_BYTES = 147456, LDSCTL_OFF = LDS_BYTES - 1024, MISC_OFF = LDSCTL_OFF + 320;

#define LDS_WAIT() asm volatile("s_waitcnt lgkmcnt(0)" ::: "memory")
#define VM_WAIT() asm volatile("s_waitcnt vmcnt(0)" ::: "memory")
__device__ __forceinline__ unsigned f2bf(float f) { unsigned u = __builtin_bit_cast(unsigned, f); return (u + 0x7fffu + ((u >> 16) & 1u)) >> 16; }
__device__ __forceinline__ unsigned pk2(float lo, float hi) { return f2bf(lo) | (f2bf(hi) << 16); }
__device__ __forceinline__ float bf2f(unsigned short b) { return __builtin_bit_cast(float, ((unsigned)b) << 16); }
__device__ __forceinline__ float bflo(unsigned w) { return __builtin_bit_cast(float, w << 16); }
__device__ __forceinline__ float bfhi(unsigned w) { return __builtin_bit_cast(float, w & 0xffff0000u); }

#define XB_TMO      128
#define XB_XCNT(j)  (256  + 64 * (j))
#define XB_XSUB(j)  (1280 + 64 * (j))
#define XB_XGEN(j)  (2304 + 64 * (j))
#define XB_TOP      3328
#define XB_TOPGEN   3392
#define XCD_BAR_WORDS 3456
#define XB_SPIN_CAP (1u << 22)
__device__ __forceinline__ unsigned xb_ld(unsigned* p)              { return __hip_atomic_load(p, __ATOMIC_RELAXED, __HIP_MEMORY_SCOPE_AGENT); }
__device__ __forceinline__ unsigned xb_add(unsigned* p, unsigned v) { return __hip_atomic_fetch_add(p, v, __ATOMIC_RELAXED, __HIP_MEMORY_SCOPE_AGENT); }
__device__ __forceinline__ unsigned xb_xcc_id() { return (unsigned)__builtin_amdgcn_s_getreg((3 << 11) | 20) & 0xFu; }
#define XB_SPIN(cond, bar) do { unsigned _sp = 0; while (cond) { __builtin_amdgcn_s_sleep(1); \
    if ((++_sp & 255u) == 0u) { if (xb_ld(&(bar)[XB_TMO])) break; if (_sp > XB_SPIN_CAP) { atomicAdd(&(bar)[XB_TMO], 1u); break; } } } } while (0)
struct XcdBarrier { unsigned* bar; unsigned x; volatile LAS unsigned* st; };
__device__ __forceinline__ XcdBarrier xcd_barrier_post(unsigned* bar, volatile LAS unsigned* st) {
    XcdBarrier b; b.bar = bar; b.x = xb_xcc_id(); b.st = st;
    if (threadIdx.x == 0) (void)xb_add(&bar[XB_XCNT(b.x)], 1u);
    return b;
}
__device__ __forceinline__ void xcd_barrier_complete(unsigned* bar, unsigned x, unsigned& nloc, unsigned& nx) {
    const unsigned G = gridDim.x * gridDim.y * gridDim.z;
    unsigned sum, cnt, mine, sp = 0u;
    for (;;) {
        sum = 0u; cnt = 0u; mine = 0u;
#pragma unroll
        for (unsigned j = 0; j < 16; ++j) { const unsigned c = xb_ld(&bar[XB_XCNT(j)]); sum += c; cnt += (c > 0u) ? 1u : 0u; mine = (j == x) ? c : mine; }
        if (sum == G) break;
        __builtin_amdgcn_s_sleep(1);
        if ((++sp & 255u) == 0u) { if (xb_ld(&bar[XB_TMO])) break; if (sp > XB_SPIN_CAP) { atomicAdd(&bar[XB_TMO], 1u); break; } }
    }
    nloc = mine > 0u ? mine : 1u; nx = cnt > 0u ? cnt : 1u;
}
__device__ __forceinline__ void xcd_barrier(const XcdBarrier& b) {
    asm volatile("s_waitcnt vmcnt(0)" ::: "memory");
    __syncthreads();
    if (threadIdx.x == 0) {
        unsigned* bar = b.bar;
        __builtin_amdgcn_s_waitcnt(0);
        unsigned nloc = b.st[0], nx = b.st[1];
        if (nloc == 0u) { xcd_barrier_complete(bar, b.x, nloc, nx); b.st[0] = nloc; b.st[1] = nx; }
        const unsigned old = xb_add(&bar[XB_XSUB(b.x)], 1u);
        const unsigned gen = old / nloc;
        if (old + 1u == (gen + 1u) * nloc) {
            __builtin_amdgcn_fence(__ATOMIC_RELEASE, "agent");
            asm volatile("s_waitcnt vmcnt(0)" ::: "memory");
            const unsigned og = xb_add(&bar[XB_TOP], 1u);
            const unsigned tg = og / nx;
            if (og + 1u == (tg + 1u) * nx) xb_add(&bar[XB_TOPGEN], 1u);
            else XB_SPIN(xb_ld(&bar[XB_TOPGEN]) == tg, bar);
            __builtin_amdgcn_fence(__ATOMIC_ACQUIRE, "agent");
            xb_add(&bar[XB_XGEN(b.x)], 1u);
            asm volatile("s_waitcnt vmcnt(0)" ::: "memory");
        } else {
            XB_SPIN(xb_ld(&bar[XB_XGEN(b.x)]) == gen, bar);
            __builtin_amdgcn_fence(__ATOMIC_ACQUIRE, "agent");
            asm volatile("s_waitcnt vmcnt(0)" ::: "memory");
        }
    }
    __syncthreads();
}

struct Args { const float* in[26]; float* out; unsigned char* ws; int ph_lo, ph_hi, chk, pad; };
struct Ctx {
    LAS unsigned char* lds; int tid, lane, wave, vcu, G;
    const float* const* in; float* out; unsigned char* ws;
};
__device__ __forceinline__ float wave_sum(float v) {
#pragma unroll
    for (int o = 1; o < 64; o <<= 1) v += __shfl_xor(v, o);
    return v;
}
#ifndef CV_NT
#define CV_NT 1
#endif
__device__ __forceinline__ void p0_transpose_item(const float* W, int K, int N, bf16* WT, int drow0, LAS float* scr, int k0, int n0, int lane) {
    const int c4 = (lane & 15) * 4, kq = lane >> 4;
    f32x4 v[16];
#pragma unroll
    for (int i = 0; i < 16; ++i) v[i] = CV_NT ? __builtin_nontemporal_load((const f32x4*)(W + (size_t)(k0 + 4 * i + kq) * N + n0 + c4)) : *(const f32x4*)(W + (size_t)(k0 + 4 * i + kq) * N + n0 + c4);
#pragma unroll
    for (int i = 0; i < 16; ++i) { LAS float* d = scr + (4 * i + kq) * 65 + c4; d[0] = v[i].x; d[1] = v[i].y; d[2] = v[i].z; d[3] = v[i].w; }
    LDS_WAIT(); asm volatile("" ::: "memory");
    const int c = lane & 7;
#pragma unroll
    for (int j = 0; j < 8; ++j) { const int n = (lane >> 3) + 8 * j; const LAS float* s = scr + (8 * c) * 65 + n;
        v4u o; o.x = pk2(s[0 * 65], s[1 * 65]); o.y = pk2(s[2 * 65], s[3 * 65]); o.z = pk2(s[4 * 65], s[5 * 65]); o.w = pk2(s[6 * 65], s[7 * 65]);
        const int dr = drow0 + n;
        GAS v4u* dp = (GAS v4u*)(WT + (((size_t)(dr >> 8) * (K >> 6) + (k0 >> 6)) * 256 + (dr & 255)) * 64 + 8 * c);
        if (CV_NT) __builtin_nontemporal_store(o, dp); else *dp = o; }
    LDS_WAIT(); asm volatile("" ::: "memory");
}
constexpr int CV_W1_ITEMS = (DM / 64) * (2 * DFF / 64), CV_W2_ITEMS = (DFF / 64) * (DM / 64), CV_WIN_ITEMS = (DM / 64) * (EVN / 64), CV_SQ_ITEMS = (DM / 64) * (DM / 64),
              CV_DOWN_ITEMS = (DM / 64) * (1600 / 64), CV_UQ_ITEMS = (1024 / 64) * (UQN / 64), CV_UKV_ITEMS = (512 / 64) * (UKVN / 64);
constexpr int CV_E0 = CV_W1_ITEMS, CV_E1 = CV_E0 + CV_W2_ITEMS, CV_E2 = CV_E1 + CV_WIN_ITEMS, CV_E3 = CV_E2 + CV_SQ_ITEMS, CV_E4 = CV_E3 + CV_W1_ITEMS, CV_E5 = CV_E4 + CV_W2_ITEMS,
              CV_E6 = CV_E5 + CV_W1_ITEMS, CV_E7 = CV_E6 + CV_W2_ITEMS, CV_E8 = CV_E7 + CV_DOWN_ITEMS, CV_E9 = CV_E8 + CV_UQ_ITEMS, CV_E10 = CV_E9 + CV_UKV_ITEMS, CV_E11 = CV_E10 + CV_SQ_ITEMS,
              CV_E12 = CV_E11 + CV_W1_ITEMS, CV_TOTAL = CV_E12 + CV_W2_ITEMS;
#ifndef CV_T2
#define CV_T2 18000
#define CV_T5 10000
#define CV_T10 18000
#define CV_T13 18000
#define CV_T16 3000
#define CV_T18 4000
#endif
constexpr int CV_P0 = CV_TOTAL - (CV_T2 + CV_T5 + CV_T10 + CV_T13 + CV_T16 + CV_T18);
constexpr int CV_S2 = CV_P0, CV_S5 = CV_S2 + CV_T2, CV_S10 = CV_S5 + CV_T5, CV_S13 = CV_S10 + CV_T10, CV_S16 = CV_S13 + CV_T13, CV_S18 = CV_S16 + CV_T16;
static_assert(CV_S18 + CV_T18 == CV_TOTAL && CV_P0 >= CV_E1, "conversion schedule: P0 must at least cover the first FFN's weights");
__device__ __forceinline__ void p0_convert(const Args& a, LAS unsigned char* lds, int first, int last, int widx, int nw, int wave, int lane) {
    LAS float* scr = (LAS float*)(lds + wave * 16640);
    unsigned char* ws = a.ws;
    for (int it = first + widx; it < last; it += nw) {
        const float* W; bf16* WT; int K, N, swi = 0, r;
        if (it < CV_E0) { r = it; W = a.in[7]; WT = (bf16*)(ws + WS_WT1); K = DM; N = 2 * DFF; swi = 1; }
        else if (it < CV_E1) { r = it - CV_E0; W = a.in[8]; WT = (bf16*)(ws + WS_WT2); K = DFF; N = DM; }
        else if (it < CV_E2) { r = it - CV_E1; W = a.in[9]; WT = (bf16*)(ws + WS_WIN); K = DM; N = EVN; }
        else if (it < CV_E3) { r = it - CV_E2; W = a.in[10]; WT = (bf16*)(ws + WS_WOUT); K = DM; N = DM; }
        else if (it < CV_E4) { r = it - CV_E3; W = a.in[7] + (size_t)1 * DM * 2 * DFF; WT = (bf16*)(ws + WS_WT1 + (size_t)1 * WT1_SZ); K = DM; N = 2 * DFF; swi = 1; }
        else if (it < CV_E5) { r = it - CV_E4; W = a.in[8] + (size_t)1 * DFF * DM; WT = (bf16*)(ws + WS_WT2 + (size_t)1 * WT2_SZ); K = DFF; N = DM; }
        else if (it < CV_E6) { r = it - CV_E5; W = a.in[7] + (size_t)2 * DM * 2 * DFF; WT = (bf16*)(ws + WS_WT1 + (size_t)2 * WT1_SZ); K = DM; N = 2 * DFF; swi = 1; }
        else if (it < CV_E7) { r = it - CV_E6; W = a.in[8] + (size_t)2 * DFF * DM; WT = (bf16*)(ws + WS_WT2 + (size_t)2 * WT2_SZ); K = DFF; N = DM; }
        else if (it < CV_E8) { r = it - CV_E7; W = a.in[16]; WT = (bf16*)(ws + WS_WDOWN); K = DM; N = 1600; }
        else if (it < CV_E9) { r = it - CV_E8; W = a.in[19]; WT = (bf16*)(ws + WS_WUQ); K = 1024; N = UQN; }
        else if (it < CV_E10) { r = it - CV_E9; W = a.in[20]; WT = (bf16*)(ws + WS_WUKV); K = 512; N = UKVN; }
        else if (it < CV_E11) { r = it - CV_E10; W = a.in[25]; WT = (bf16*)(ws + WS_WO); K = DM; N = DM; }
        else if (it < CV_E12) { r = it - CV_E11; W = a.in[7] + (size_t)3 * DM * 2 * DFF; WT = (bf16*)(ws + WS_WT1 + (size_t)3 * WT1_SZ); K = DM; N = 2 * DFF; swi = 1; }
        else { r = it - CV_E12; W = a.in[8] + (size_t)3 * DFF * DM; WT = (bf16*)(ws + WS_WT2 + (size_t)3 * WT2_SZ); K = DFF; N = DM; }
        const int nblk = N / 64, kb = r / nblk, nb = r - kb * nblk, n0 = 64 * nb;
        int drow0 = n0;
        if (swi) { drow0 = n0 < DFF ? (n0 >> 7) * 256 + (n0 & 127) : ((n0 - DFF) >> 7) * 256 + 128 + ((n0 - DFF) & 127); }
        p0_transpose_item(W, K, N, WT, drow0, scr, 64 * kb, n0, lane);
    }
}
__device__ __forceinline__ void tail_convert(const Args& a, LAS unsigned char* lds, int nwg, int G, int c, int first, int count, int wave, int lane) {
    const int rem = nwg % G, nfree = rem == 0 ? G : G - rem, f = rem == 0 ? c : c - rem;
    if (f < 0) return;
    __syncthreads();
    p0_convert(a, lds, first, first + count, f * NWAVES + wave, nfree * NWAVES, wave, lane);
}
__device__ __forceinline__ float silu_f(float x) { return x / (1.0f + __expf(-x)); }
__device__ __forceinline__ void p0_mod(const Args& a, LAS unsigned char* lds, int c, int G, int tid) {
    LAS float* sl = (LAS float*)lds;
    LAS float* red = (LAS float*)(lds + 49152);
    for (int i = tid; i < 3 * DM; i += 512) { const int v = i >> 12, k = i & 4095; const float x = v < 2 ? a.in[1][v * DM + k] : a.in[3][k]; sl[i] = silu_f(x); }
    __syncthreads();
    const int cl = tid & 15, ks = tid >> 4;
    float* mod = (float*)(a.ws + WS_MOD);
    constexpr int NCG = NMOD * DM / 64;
    for (int u = c; u < 2 * NCG; u += G) {
        const int l = u / NCG, cg = u - l * NCG;
        const float* wp = a.in[5] + ((size_t)l * DM + ks * 128) * (NMOD * DM) + cg * 64 + cl * 4;
        f32x4 a0 = {0.f, 0.f, 0.f, 0.f}, a1 = a0, a2 = a0;
#pragma unroll 8
        for (int k = 0; k < 128; ++k) { const f32x4 w = *(const f32x4*)(wp + (size_t)k * (NMOD * DM)); const int kk = ks * 128 + k;
            a0 += w * sl[kk]; a1 += w * sl[DM + kk]; a2 += w * sl[2 * DM + kk]; }
        LAS float* rp = red + (ks * 16 + cl) * 12;
        *(LAS f32x4*)(rp) = a0; *(LAS f32x4*)(rp + 4) = a1; *(LAS f32x4*)(rp + 8) = a2;
        __syncthreads();
        if (tid < 192) { const int cl2 = tid & 15, comp = tid >> 4; float s = 0.f;
#pragma unroll 8
            for (int q = 0; q < 32; ++q) s += red[(q * 16 + cl2) * 12 + comp];
            const int v = comp >> 2, e = comp & 3, col = cg * 64 + cl2 * 4 + e;
            mod[((size_t)l * 3 + v) * (NMOD * DM) + col] = s + a.in[6][l * (NMOD * DM) + col]; }
        __syncthreads();
    }
}
__device__ __forceinline__ void p0_zero_pad(const Args& a, int c, int G, int tid) {
    const v4u z = {0u, 0u, 0u, 0u}; constexpr int PER = 192 * 64 * 2 / 16;
    for (int i = c * 512 + tid; i < 64 * PER; i += G * 512) { const int kb = i / PER, r = i - kb * PER;
        v4u* p = (v4u*)(a.ws + WS_WDOWN + ((((size_t)6 * 64 + kb) * 256 + 64) * 64) * 2); p[r] = z; }
}

__device__ __forceinline__ void modulate_phase(const float* src_lat, const float* src_ctx, const float* g, const float* modl  , int ishift, int iscale,
                                               bf16* U, int M, int gw, int NGW, int lane, const float* slab, const float* sgate, float gs, float* hout_ctx) {
    for (int row = gw; row < M; row += NGW) {
        const float* src = row < NLAT ? src_lat + (size_t)row * DM : src_ctx + (size_t)(row - NLAT) * DM;
        const int vec = row < SEQ ? 0 : (row < NLAT ? 1 : 2);
        const float* sh = modl + ((size_t)vec * NMOD + ishift) * DM; const float* sc = modl + ((size_t)vec * NMOD + iscale) * DM;
        f32x4 v[16]; float ss = 0.f;
#pragma unroll
        for (int j = 0; j < 16; ++j) v[j] = *(const f32x4*)(src + 4 * (lane + 64 * j));
        if (slab != nullptr && row >= NLAT) {
            const float* sp = slab + (size_t)(row - NLAT) * DM; float* ho = hout_ctx + (size_t)(row - NLAT) * DM;
#pragma unroll
            for (int j = 0; j < 16; ++j) {
                const int ci = 4 * (lane + 64 * j); f32x4 t[8]; const f32x4 gt = *(const f32x4*)(sgate + ci);
#pragma unroll
                for (int s = 0; s < 8; ++s) t[s] = *(const f32x4*)(sp + (size_t)s * 512 * DM + ci);
                const f32x4 sum = ((t[0] + t[1]) + (t[2] + t[3])) + ((t[4] + t[5]) + (t[6] + t[7]));
                v[j] += (gt * gs) * sum; *(f32x4*)(ho + ci) = v[j]; }
        }
#pragma unroll
        for (int j = 0; j < 16; ++j) ss += (v[j].x * v[j].x + v[j].y * v[j].y) + (v[j].z * v[j].z + v[j].w * v[j].w);
        const float rstd = 1.0f / sqrtf(wave_sum(ss) * (1.0f / DM) + EPS);
        v2u* o8 = (v2u*)(U + (size_t)row * DM);
#pragma unroll
        for (int jc = 0; jc < 16; jc += 4) {
            f32x4 gg[4], s1[4], s0[4];
#pragma unroll
            for (int jj = 0; jj < 4; ++jj) { const int ci = 4 * (lane + 64 * (jc + jj)); gg[jj] = *(const f32x4*)(g + ci); s1[jj] = *(const f32x4*)(sc + ci); s0[jj] = *(const f32x4*)(sh + ci); }
#pragma unroll
            for (int jj = 0; jj < 4; ++jj) { const int j = jc + jj; const f32x4 y = (v[j] * rstd) * gg[jj] * (s1[jj] + 1.0f) + s0[jj];
                v2u w; w.x = pk2(y.x, y.y); w.y = pk2(y.z, y.w); o8[lane + 64 * j] = w; }
        }
    }
}

__device__ __forceinline__ void rope_cs(float pos, int f, float l2step  , float& c, float& s) {
    const float ang = pos * __builtin_amdgcn_exp2f(-(float)f * l2step);
    const float rev = ang * 0.15915494309189535f;
    s = __builtin_amdgcn_sinf(rev); c = __builtin_amdgcn_cosf(rev);
}
__device__ __forceinline__ void unpack8(const v4u w, float (&x)[8]) { x[0] = bflo(w.x); x[1] = bfhi(w.x); x[2] = bflo(w.y); x[3] = bfhi(w.y); x[4] = bflo(w.z); x[5] = bfhi(w.z); x[6] = bflo(w.w); x[7] = bfhi(w.w); }
__device__ __forceinline__ v4u pack8(const float (&x)[8]) { v4u w; w.x = pk2(x[0], x[1]); w.y = pk2(x[2], x[3]); w.z = pk2(x[4], x[5]); w.w = pk2(x[6], x[7]); return w; }
__device__ __forceinline__ float sum16(float v) { v += __shfl_xor(v, 1); v += __shfl_xor(v, 2); v += __shfl_xor(v, 4); v += __shfl_xor(v, 8); return v; }

template <int KIND  >
__device__ __forceinline__ void prep_even_group(const v4u w, int lane, bool latent, float prow_f, float pcol_f, const f32x4 g0, const f32x4 g1, bf16* dst  , int dst_slot_stride) {
    const int i = lane & 15, sl = lane >> 4;
    bf16* d = dst + (size_t)sl * dst_slot_stride + i * 8;
    if constexpr (KIND == 3 || KIND == 5) { *(v4u*)d = w; return; }
    float x[8]; unpack8(w, x);
    float ss = 0.f;
#pragma unroll
    for (int e = 0; e < 8; ++e) ss += x[e] * x[e];
    const float rstd = 1.0f / sqrtf(sum16(ss) * (1.0f / 128.0f) + EPS);
    x[0] *= rstd * g0.x; x[1] *= rstd * g0.y; x[2] *= rstd * g0.z; x[3] *= rstd * g0.w; x[4] *= rstd * g1.x; x[5] *= rstd * g1.y; x[6] *= rstd * g1.z; x[7] *= rstd * g1.w;
    if constexpr (KIND == 1 || KIND == 4) {
        const int i8 = i & 7; const float pos = i8 < 4 ? prow_f : pcol_f; const int f0 = (i8 & 3) * 8;
#pragma unroll
        for (int e = 0; e < 8; ++e) { const float other = __shfl_xor(x[e], 8); float c, s; rope_cs(pos, f0 + e, 0.41524101186092029f, c, s);
            const float r = i < 8 ? x[e] * c - other * s : other * s + x[e] * c; x[e] = latent ? r : x[e]; }
    }
    *(v4u*)d = pack8(x);
}
__device__ __forceinline__ void prep_even_phase(const Args& a, int gw, int NGW, int lane) {
    unsigned char* ws = a.ws; const bf16* P = (const bf16*)(ws + WS_P);
    bf16* QB = (bf16*)(ws + WS_QB); bf16* KN = (bf16*)(ws + WS_KN); bf16* VN = (bf16*)(ws + WS_VN); bf16* KG = (bf16*)(ws + WS_KG); bf16* VG = (bf16*)(ws + WS_VG);
    const int gi_ = (lane & 15) * 8; const f32x4 z4 = {0.f, 0.f, 0.f, 0.f};
    const f32x4 nq0 = *(const f32x4*)(a.in[11] + gi_), nq1 = *(const f32x4*)(a.in[11] + gi_ + 4), gq0 = *(const f32x4*)(a.in[14] + gi_), gq1 = *(const f32x4*)(a.in[14] + gi_ + 4);
    const f32x4 nk0 = *(const f32x4*)(a.in[12] + gi_), nk1 = *(const f32x4*)(a.in[12] + gi_ + 4), gk0 = *(const f32x4*)(a.in[15] + gi_), gk1 = *(const f32x4*)(a.in[15] + gi_ + 4);
    for (int row = gw; row < MROWS; row += NGW) {
        const bool latent = row < NLAT; const int b = latent ? row >> 12 : (row - NLAT) >> 8; const int kidx = latent ? CTXL + (row & 4095) : (row - NLAT) & 255; const int t = row & 4095;
        const float prow_f = (float)(t >> 6), pcol_f = (float)(t & 63);
        const bf16* prow = P + (size_t)row * EVN; const size_t krow = (size_t)b * NKEY + kidx;
        v4u w[18];
#pragma unroll
        for (int grp = 0; grp < 18; ++grp) w[grp] = *(const v4u*)(prow + grp * 512 + lane * 8);
#pragma unroll
        for (int grp = 0; grp < 4; ++grp) prep_even_group<0>(w[grp], lane, latent, prow_f, pcol_f, nq0, nq1, QB + (size_t)row * DM + grp * 512, 128);
#pragma unroll
        for (int grp = 4; grp < 8; ++grp) prep_even_group<1>(w[grp], lane, latent, prow_f, pcol_f, gq0, gq1, QB + (size_t)row * DM + grp * 512, 128);
#pragma unroll
        for (int grp = 8; grp < 12; ++grp) prep_even_group<2>(w[grp], lane, latent, prow_f, pcol_f, nk0, nk1, KN + krow * 2048 + (grp - 8) * 512, 128);
#pragma unroll
        for (int grp = 12; grp < 16; ++grp) prep_even_group<3>(w[grp], lane, latent, prow_f, pcol_f, z4, z4, VN + krow * 2048 + (grp - 12) * 512, 128);
        prep_even_group<4>(w[16], lane, latent, prow_f, pcol_f, gk0, gk1, KG + krow * 512, 128);
        prep_even_group<5>(w[17], lane, latent, prow_f, pcol_f, z4, z4, VG + krow * 512, 128);
    }
}

__device__ __forceinline__ void prep_mla1_phase(const Args& a, int gw, int NGW, int lane) {
    unsigned char* ws = a.ws; const float* DL = (const float*)(ws + WS_DL);
    bf16* CQN = (bf16*)(ws + WS_CQN); bf16* CKVN = (bf16*)(ws + WS_CKVN); bf16* KR = (bf16*)(ws + WS_KR);
    for (int row = gw; row < MROWS; row += NGW) {
        const float* d = DL + (size_t)row * DLN; const bool latent = row < NLAT; const int t = row & 4095;
        f32x4 q[4], kv[2], gq[4], gk[2]; float ss = 0.f;
#pragma unroll
        for (int j = 0; j < 4; ++j) { q[j] = *(const f32x4*)(d + 4 * (lane + 64 * j)); gq[j] = *(const f32x4*)(a.in[17] + 4 * (lane + 64 * j)); }
#pragma unroll
        for (int j = 0; j < 2; ++j) { kv[j] = *(const f32x4*)(d + 1024 + 4 * (lane + 64 * j)); gk[j] = *(const f32x4*)(a.in[18] + 4 * (lane + 64 * j)); }
        float x = d[1536 + lane]; const float gx = a.in[24][lane];
#pragma unroll
        for (int j = 0; j < 4; ++j) ss += (q[j].x * q[j].x + q[j].y * q[j].y) + (q[j].z * q[j].z + q[j].w * q[j].w);
        float rstd = 1.0f / sqrtf(wave_sum(ss) * (1.0f / 1024.0f) + EPS);
#pragma unroll
        for (int j = 0; j < 4; ++j) { const int ci = 4 * (lane + 64 * j); const f32x4 y = q[j] * rstd * gq[j];
            v2u w; w.x = pk2(y.x, y.y); w.y = pk2(y.z, y.w); *(v2u*)(CQN + (size_t)row * 1024 + ci) = w; }
        ss = 0.f;
#pragma unroll
        for (int j = 0; j < 2; ++j) ss += (kv[j].x * kv[j].x + kv[j].y * kv[j].y) + (kv[j].z * kv[j].z + kv[j].w * kv[j].w);
        rstd = 1.0f / sqrtf(wave_sum(ss) * (1.0f / 512.0f) + EPS);
#pragma unroll
        for (int j = 0; j < 2; ++j) { const int ci = 4 * (lane + 64 * j); const f32x4 y = kv[j] * rstd * gk[j];
            v2u w; w.x = pk2(y.x, y.y); w.y = pk2(y.z, y.w); *(v2u*)(CKVN + (size_t)row * 512 + ci) = w; }
        rstd = 1.0f / sqrtf(wave_sum(x * x) * (1.0f / 64.0f) + EPS);
        x = x * rstd * gx;
        { const int aidx = lane & 31; const float pos = aidx < 16 ? (float)(t >> 6) : (float)(t & 63); float c, s; rope_cs(pos, aidx & 15, 0.83048202372184058f, c, s);
          const float other = __shfl_xor(x, 32); const float r = lane < 32 ? x * c - other * s : other * s + x * c; x = latent ? r : x; }
        KR[(size_t)row * 64 + lane] = (bf16)f2bf(x);
    }
}
__device__ __forceinline__ void prep_mla2_phase(const Args& a, int gw, int NGW, int lane) {
    unsigned char* ws = a.ws; const bf16* QRAW = (const bf16*)(ws + WS_QRAW); const bf16* KVRAW = (const bf16*)(ws + WS_KVRAW); const bf16* KR = (const bf16*)(ws + WS_KR);
    bf16* QM = (bf16*)(ws + WS_QM); bf16* KM = (bf16*)(ws + WS_KM); bf16* VM = (bf16*)(ws + WS_VM);
    const int i = lane & 15, g4 = lane >> 4;
    for (int item = gw; item < NLAT + MROWS; item += NGW) {
        if (item < NLAT) {
            const int row = item, t = row & 4095; const bf16* src = QRAW + (size_t)row * UQN; bf16* dst = QM + (size_t)row * UQN;
            const f32x4 gn0 = *(const f32x4*)(a.in[21] + i * 8), gn1 = *(const f32x4*)(a.in[21] + i * 8 + 4);
            const int i8 = i & 7; const f32x4 gr0 = *(const f32x4*)(a.in[22] + i8 * 8), gr1 = *(const f32x4*)(a.in[22] + i8 * 8 + 4);
            const int i4 = i & 3; const float pos = i4 < 2 ? (float)(t >> 6) : (float)(t & 63); const int f0 = (i4 & 1) * 8;
            v4u wn[8], wr[8];
#pragma unroll
            for (int it = 0; it < 8; ++it) { const int h = it * 4 + g4; wn[it] = *(const v4u*)(src + h * 192 + i * 8); wr[it] = *(const v4u*)(src + h * 192 + 128 + i8 * 8); }
#pragma unroll
            for (int it = 0; it < 8; ++it) { const int h = it * 4 + g4;
                float x[8]; unpack8(wn[it], x);
                float ss = 0.f;
#pragma unroll
                for (int e = 0; e < 8; ++e) ss += x[e] * x[e];
                float rstd = 1.0f / sqrtf(sum16(ss) * (1.0f / 128.0f) + EPS);
                x[0] *= rstd * gn0.x; x[1] *= rstd * gn0.y; x[2] *= rstd * gn0.z; x[3] *= rstd * gn0.w; x[4] *= rstd * gn1.x; x[5] *= rstd * gn1.y; x[6] *= rstd * gn1.z; x[7] *= rstd * gn1.w;
                *(v4u*)(dst + h * 192 + i * 8) = pack8(x);
                float y[8]; unpack8(wr[it], y);
                ss = 0.f;
#pragma unroll
                for (int e = 0; e < 8; ++e) ss += y[e] * y[e];
                ss = i < 8 ? ss : 0.f;
                rstd = 1.0f / sqrtf(sum16(ss) * (1.0f / 64.0f) + EPS);
                y[0] *= rstd * gr0.x; y[1] *= rstd * gr0.y; y[2] *= rstd * gr0.z; y[3] *= rstd * gr0.w; y[4] *= rstd * gr1.x; y[5] *= rstd * gr1.y; y[6] *= rstd * gr1.z; y[7] *= rstd * gr1.w;
#pragma unroll
                for (int e = 0; e < 8; ++e) { const float other = __shfl_xor(y[e], 4); float c, s; rope_cs(pos, f0 + e, 0.83048202372184058f, c, s);
                    y[e] = i8 < 4 ? y[e] * c - other * s : other * s + y[e] * c; }
                if (i < 8) *(v4u*)(dst + h * 192 + 128 + i * 8) = pack8(y);
            }
        } else {
            const int row = item - NLAT; const bool latent = row < NLAT; const int b = latent ? row >> 12 : (row - NLAT) >> 8; const int kidx = latent ? CTXL + (row & 4095) : (row - NLAT) & 255;
            const bf16* src = KVRAW + (size_t)row * UKVN; const size_t krow = (size_t)b * NKEY + kidx; bf16* kd = KM + krow * UQN; bf16* vd = VM + krow * DM;
            const f32x4 gn0 = *(const f32x4*)(a.in[23] + i * 8), gn1 = *(const f32x4*)(a.in[23] + i * 8 + 4);
            const v4u krw = *(const v4u*)(KR + (size_t)row * 64 + (i & 7) * 8);
            v4u wk[8], wv[8];
#pragma unroll
            for (int it = 0; it < 8; ++it) { const int h = it * 4 + g4; wk[it] = *(const v4u*)(src + h * 256 + i * 8); wv[it] = *(const v4u*)(src + h * 256 + 128 + i * 8); }
#pragma unroll
            for (int it = 0; it < 8; ++it) { const int h = it * 4 + g4;
                float x[8]; unpack8(wk[it], x);
                float ss = 0.f;
#pragma unroll
                for (int e = 0; e < 8; ++e) ss += x[e] * x[e];
                const float rstd = 1.0f / sqrtf(sum16(ss) * (1.0f / 128.0f) + EPS);
                x[0] *= rstd * gn0.x; x[1] *= rstd * gn0.y; x[2] *= rstd * gn0.z; x[3] *= rstd * gn0.w; x[4] *= rstd * gn1.x; x[5] *= rstd * gn1.y; x[6] *= rstd * gn1.z; x[7] *= rstd * gn1.w;
                *(v4u*)(kd + h * 192 + i * 8) = pack8(x);
                *(v4u*)(vd + h * 128 + i * 8) = wv[it];
                if (i < 8) *(v4u*)(kd + h * 192 + 128 + i * 8) = krw;
            }
        }
    }
}

__device__ __forceinline__ void attn_even_phase(const Args& a, unsigned char* lds_g, LAS unsigned char* lds, int c, int G, int tid) {
    unsigned char* ws = a.ws; const bf16* QB = (const bf16*)(ws + WS_QB); const bf16* KN = (const bf16*)(ws + WS_KN); const bf16* VN = (const bf16*)(ws + WS_VN);
    const bf16* KG = (const bf16*)(ws + WS_KG); const bf16* VG = (const bf16*)(ws + WS_VG); bf16* AO = (bf16*)(ws + WS_AO);
    const int wave = tid >> 6, lane = tid & 63;
    LAS float* rpbS = (LAS float*)(lds + att::Cfg<128>::SHM_RPB);
    for (int gi = c; gi < 1088; gi += G) {
        const bf16 *Qp, *Kp, *Vp; bf16* Op; int ldk, NT, seg2 = 0; att::NaWave nw; nw.na = 0; nw.r0w = 0; nw.rq = 0; nw.cq = 0; nw.c0 = 0; nw.rlo = 0; nw.rpb = rpbS;
        if (gi < 512) {
            const int xg = gi & 7, u = gi >> 3, b = xg >> 2, kvh = xg & 3, h = kvh * 4 + (u >> 4), qb = u & 15;
            const size_t qrow = (size_t)b * SEQ + qb * 256;
            Qp = QB + qrow * DM + 2048 + h * 128; Op = AO + qrow * DM + 2048 + h * 128; Kp = KG + (size_t)b * NKEY * 512 + kvh * 128; Vp = VG + (size_t)b * NKEY * 512 + kvh * 128; ldk = 512; NT = NKEY / 64;
        } else if (gi < 1024) {
            const int L = gi - 512, xg = L & 7, u = L >> 3, pair = xg * 4 + (u >> 4), Rg = u & 15, b = pair >> 4, h = pair & 15;
            const size_t qrow = (size_t)b * SEQ + Rg * 256;
            Qp = QB + qrow * DM + h * 128; Op = AO + qrow * DM + h * 128; Kp = KN + (size_t)b * NKEY * 2048 + h * 128; Vp = VN + (size_t)b * NKEY * 2048 + h * 128; ldk = 2048;
            const int rlo = min(max(4 * Rg - 4, 0), 56), nb = (Rg == 0 || Rg == 15) ? 8 : 12;
            NT = 4 + nb; seg2 = rlo * 64;
            const int rq = 4 * Rg + (wave >> 1), cq = (wave & 1) * 32 + (lane & 31);
            nw.na = 1; nw.rq = rq; nw.r0w = min(max(rq - 4, 0), 56); nw.cq = cq; nw.c0 = min(max(cq - 8, 0), 48); nw.rlo = rlo;
            __syncthreads();
            if (tid < 465) rpbS[tid] = a.in[13][h * 465 + tid] * (1.0f / att::Cfg<128>::SCALE);
        } else {
            const int L = gi - 1024, ty = L >> 5, b = (L >> 4) & 1, h = L & 15;
            const size_t qrow = (size_t)NLAT + b * CTXL;
            if (ty == 0) { Qp = QB + qrow * DM + h * 128; Op = AO + qrow * DM + h * 128; Kp = KN + (size_t)b * NKEY * 2048 + h * 128; Vp = VN + (size_t)b * NKEY * 2048 + h * 128; ldk = 2048; }
            else { Qp = QB + qrow * DM + 2048 + h * 128; Op = AO + qrow * DM + 2048 + h * 128; Kp = KG + (size_t)b * NKEY * 512 + (h >> 2) * 128; Vp = VG + (size_t)b * NKEY * 512 + (h >> 2) * 128; ldk = 512; }
            NT = 4;
        }
        att::attn_body<128, true>(Qp, DM, Kp, ldk, Vp, ldk, Op, DM, NT, seg2, nw, (char*)lds_g);
    }
}
__device__ __forceinline__ void attn_mla_phase(const Args& a, unsigned char* lds_g, int c, int G) {
    unsigned char* ws = a.ws; const bf16* QM = (const bf16*)(ws + WS_QM); const bf16* KM = (const bf16*)(ws + WS_KM); const bf16* VM = (const bf16*)(ws + WS_VM); bf16* AO = (bf16*)(ws + WS_AO);
    att::NaWave nw; nw.na = 0; nw.r0w = 0; nw.rq = 0; nw.cq = 0; nw.c0 = 0; nw.rlo = 0; nw.rpb = nullptr;
    for (int gi = c; gi < 1024; gi += G) {
        const int xg = gi & 7, u = gi >> 3, pair = xg * 8 + (u >> 4), qb = u & 15, b = pair >> 5, h = pair & 31;
        const size_t qrow = (size_t)b * SEQ + qb * 256;
        att::attn_body<192, false>(QM + qrow * UQN + h * 192, UQN, KM + (size_t)b * NKEY * UQN + h * 192, UQN, VM + (size_t)b * NKEY * DM + h * 128, DM, AO + qrow * DM + h * 128, DM, NKEY / 64, 0, nw, (char*)lds_g);
    }
}
constexpr int NPHASE = 25;
__global__ void __launch_bounds__(NWAVES * 64, 2) fwd_kernel(Args args) {
    extern __shared__ __attribute__((aligned(16))) unsigned char lds_g[];
    LAS unsigned char* lds = (LAS unsigned char*)lds_g;
    const int tid = threadIdx.x, lane = tid & 63, wave = __builtin_amdgcn_readfirstlane(tid >> 6);
    const int G = gridDim.x, c = blockIdx.x;
    const int vcu = (G % 8 == 0) ? (c % 8) * (G / 8) + c / 8 : c;
    const int gw = vcu * NWAVES + wave, NGW = G * NWAVES;
    unsigned char* ws = args.ws;
    volatile LAS unsigned* MISC = (volatile LAS unsigned*)(lds + MISC_OFF);
    for (int u = tid; u < (LDS_BYTES - LDSCTL_OFF) / 4; u += NWAVES * 64) ((LAS unsigned*)(lds + LDSCTL_OFF))[u] = 0u;
    __syncthreads();
    XcdBarrier bar; bar.bar = (unsigned*)(ws + WS_CTL) + CW_BAR; bar.x = 0; bar.st = nullptr;
    if (ONE_LAUNCH) bar = xcd_barrier_post((unsigned*)(ws + WS_CTL) + CW_BAR, MISC + 8);
    const int lo = args.ph_lo, hi = args.ph_hi;
#define IN(k) (lo <= (k) && (k) < hi)
#define PH_BEGIN(k) if (IN(k))
    constexpr int FFN1_NMAJ = 4, INP_NMAJ = 0, RES_NMAJ = 0;
#define SEAM(k) do { if (ONE_LAUNCH && IN(k) && IN((k) + 1)) xcd_barrier(bar); } while (0)
    float* MOD = (float*)(ws + WS_MOD);
    bf16* U = (bf16*)(ws + WS_U); bf16* HID = (bf16*)(ws + WS_HID); bf16* AO = (bf16*)(ws + WS_AO);
    float* HA = (float*)(ws + WS_HA); float* HB = (float*)(ws + WS_HB);
    const float* X = args.in[0]; const float* CTXI = args.in[2]; const float* NG = args.in[4];
    const float* MOD0 = MOD; const float* MOD1 = MOD + 3 * NMOD * DM;
    float* SLAB = (float*)(ws + WS_SLAB); const float* NOSLAB = nullptr;
    const float* GC0 = MOD0 + (size_t)2 * NMOD * DM; const float* GC1 = MOD1 + (size_t)2 * NMOD * DM;

#define PH_MODULATE(k, srcl, srcc, gptr, modl, ish, isc, Mrows, slabp, sgatep, gsv, houtc) PH_BEGIN(k) { modulate_phase(srcl, srcc, gptr, modl, ish, isc, U, Mrows, gw, NGW, lane, slabp, sgatep, gsv, houtc); } SEAM(k);
#define PH_FFN1(k, widx, Mrows, cvfirst, cvcount) PH_BEGIN(k) { pg8::Gemm g{U, (const bf16*)(ws + WS_WT1 + (size_t)(widx) * WT1_SZ), Mrows, 2 * DFF, DM, DM, 0}; pg8::StaticOrder S; S.init(Mrows, 2 * DFF, G, c, DM, FFN1_NMAJ); \
        pg8::EpiSwiglu E{HID, DFF}; pg8::gemm_phase<pg8::EpiSwiglu, pg8::StaticOrder, PG8_ALIGN, PG8_SP2>(lds, g, S, E); \
        if ((cvcount) > 0) tail_convert(args, lds, ((Mrows) / 256) * (2 * DFF / 256), G, c, cvfirst, cvcount, wave, lane); } SEAM(k);
#define PH_RESID(k, Aptr, Wptr, Kdim, Mrows, rl, rc, outp, gatep, gsv) PH_BEGIN(k) { pg8::Gemm g{Aptr, (const bf16*)(Wptr), Mrows, DM, Kdim, Kdim, 0}; pg8::StaticOrder S; S.init(Mrows, DM, G, c, Kdim, RES_NMAJ); \
        pg8::EpiResid E{rl, rc, outp, gatep, gsv}; pg8::gemm_phase<pg8::EpiResid, pg8::StaticOrder, PG8_ALIGN, PG8_SP2>(lds, g, S, E); } SEAM(k);
#define PH_RESID_SPLIT(k, Aptr, Wptr, Kdim, rl, rc, outp, gatep, gsv) PH_BEGIN(k) { pg8::Gemm g{Aptr, (const bf16*)(Wptr), MROWS, DM, Kdim, Kdim, 0}; pg8::SplitOrder S; S.init(G, c, Kdim); \
        pg8::EpiResidSplit E{{rl, rc, outp, gatep, gsv}, SLAB}; pg8::gemm_phase<pg8::EpiResidSplit, pg8::SplitOrder, PG8_ALIGN, PG8_SP2>(lds, g, S, E); } SEAM(k);

    PH_BEGIN(0) { p0_convert(args, lds, 0, CV_P0, gw, NGW, wave, lane); p0_zero_pad(args, c, G, tid); __syncthreads(); p0_mod(args, lds, c, G, tid); } SEAM(0);

    PH_MODULATE(1, X, CTXI, NG + 0 * DM, MOD0, 0, 1, MROWS, NOSLAB, NOSLAB, 0.f, (float*)nullptr)
    PH_FFN1(2, 0, MROWS, CV_S2, CV_T2)
    PH_RESID_SPLIT(3, HID, ws + WS_WT2 + 0 * WT2_SZ, DFF, X, CTXI, HA, MOD0 + 2 * DM, 0.5f)
    PH_MODULATE(4, HA, CTXI, NG + 1 * DM, MOD0, 3, 4, MROWS, SLAB, GC0 + 2 * DM, 0.5f, HA + (size_t)NLAT * DM)
    PH_BEGIN(5) { pg8::Gemm g{U, (const bf16*)(ws + WS_WIN), MROWS, EVN, DM, DM, 0}; pg8::StaticOrder S; S.init(MROWS, EVN, G, c, DM, INP_NMAJ);
        pg8::EpiBf16P E{(bf16*)(ws + WS_P), EVN}; pg8::gemm_phase<pg8::EpiBf16P, pg8::StaticOrder, PG8_ALIGN, PG8_SP2>(lds, g, S, E);
        tail_convert(args, lds, (MROWS / 256) * (EVN / 256), G, c, CV_S5, CV_T5, wave, lane); } SEAM(5);
    PH_BEGIN(6) { prep_even_phase(args, gw, NGW, lane); } SEAM(6);
    PH_BEGIN(7) { attn_even_phase(args, lds_g, lds, c, G, tid); } SEAM(7);
    PH_RESID_SPLIT(8, AO, ws + WS_WOUT, DM, HA, HA + (size_t)NLAT * DM, HB, MOD0 + 5 * DM, 1.0f)
    PH_MODULATE(9, HB, HA + (size_t)NLAT * DM, NG + 2 * DM, MOD0, 6, 7, MROWS, SLAB, GC0 + 5 * DM, 1.0f, HB + (size_t)NLAT * DM)
    PH_FFN1(10, 1, MROWS, CV_S10, CV_T10)
    PH_RESID_SPLIT(11, HID, ws + WS_WT2 + 1 * WT2_SZ, DFF, HB, HB + (size_t)NLAT * DM, HA, MOD0 + 8 * DM, 0.5f)

    PH_MODULATE(12, HA, HB + (size_t)NLAT * DM, NG + 3 * DM, MOD1, 0, 1, MROWS, SLAB, GC0 + 8 * DM, 0.5f, HA + (size_t)NLAT * DM)
    PH_FFN1(13, 2, MROWS, CV_S13, CV_T13)
    PH_RESID_SPLIT(14, HID, ws + WS_WT2 + 2 * WT2_SZ, DFF, HA, HA + (size_t)NLAT * DM, HB, MOD1 + 2 * DM, 0.5f)
    PH_MODULATE(15, HB, HA + (size_t)NLAT * DM, NG + 4 * DM, MOD1, 3, 4, MROWS, SLAB, GC1 + 2 * DM, 0.5f, HB + (size_t)NLAT * DM)
    PH_BEGIN(16) { pg8::Gemm g{U, (const bf16*)(ws + WS_WDOWN), MROWS, DLN, DM, DM, 0}; pg8::StaticOrder S; S.init(MROWS, DLN, G, c, DM);
        pg8::EpiF32P E{(float*)(ws + WS_DL), DLN}; pg8::gemm_phase<pg8::EpiF32P, pg8::StaticOrder, PG8_ALIGN, PG8_SP2>(lds, g, S, E);
        tail_convert(args, lds, (MROWS / 256) * (DLN / 256), G, c, CV_S16, CV_T16, wave, lane); } SEAM(16);
    PH_BEGIN(17) { prep_mla1_phase(args, gw, NGW, lane); } SEAM(17);
    PH_BEGIN(18) {
        { pg8::Gemm g{(const bf16*)(ws + WS_CQN), (const bf16*)(ws + WS_WUQ), NLAT, UQN, 1024, 1024, 0}; pg8::StaticOrder S; S.init(NLAT, UQN, G, c, 1024);
          pg8::EpiBf16P E{(bf16*)(ws + WS_QRAW), UQN}; pg8::gemm_phase<pg8::EpiBf16P, pg8::StaticOrder, PG8_ALIGN, PG8_SP2>(lds, g, S, E); }
        { pg8::Gemm g{(const bf16*)(ws + WS_CKVN), (const bf16*)(ws + WS_WUKV), MROWS, UKVN, 512, 512, 0}; pg8::StaticOrder S; S.init(MROWS, UKVN, G, c, 512);
          pg8::EpiBf16P E{(bf16*)(ws + WS_KVRAW), UKVN}; pg8::gemm_phase<pg8::EpiBf16P, pg8::StaticOrder, PG8_ALIGN, PG8_SP2>(lds, g, S, E); }
        tail_convert(args, lds, (MROWS / 256) * (UKVN / 256), G, c, CV_S18, CV_T18, wave, lane);
    } SEAM(18);
    PH_BEGIN(19) { prep_mla2_phase(args, gw, NGW, lane); } SEAM(19);
    PH_BEGIN(20) { attn_mla_phase(args, lds_g, c, G); } SEAM(20);
    PH_RESID(21, AO, ws + WS_WO, DM, NLAT, HB, HB, HA, MOD1 + 5 * DM, 1.0f)
    PH_MODULATE(22, HA, HA, NG + 5 * DM, MOD1, 6, 7, NLAT, NOSLAB, NOSLAB, 0.f, (float*)nullptr)
    PH_FFN1(23, 3, NLAT, 0, 0)
    PH_RESID(24, HID, ws + WS_WT2 + 3 * WT2_SZ, DFF, NLAT, HA, HA, args.out, MOD1 + 8 * DM, 0.5f)
#undef IN
#undef SEAM
}

extern "C" void kernel_launch(void* const* d_in, const int* in_sizes, int n_in, void* d_out, int out_size, void* d_ws, size_t ws_size, hipStream_t stream) {
    static int grid = 0;
    if (grid == 0) {
        if (n_in != 26 || out_size != NLAT * DM || ws_size < WS_END) { fprintf(stderr, "kernel_launch: unexpected shapes (n_in %d out %d ws %zu)\n", n_in, out_size, ws_size); grid = -1; return; }
        int dev = 0, cus = 0, per_cu = 0;
        if (hipGetDevice(&dev) != hipSuccess || hipDeviceGetAttribute(&cus, hipDeviceAttributeMultiprocessorCount, dev) != hipSuccess) { grid = -1; return; }
        if (hipFuncSetAttribute((const void*)fwd_kernel, hipFuncAttributeMaxDynamicSharedMemorySize, LDS_BYTES) != hipSuccess) { fprintf(stderr, "kernel_launch: hipFuncSetAttribute failed\n"); grid = -1; return; }
        if (hipOccupancyMaxActiveBlocksPerMultiprocessor(&per_cu, (const void*)fwd_kernel, NWAVES * 64, LDS_BYTES) != hipSuccess || per_cu < 1) { fprintf(stderr, "kernel_launch: occupancy query reports %d\n", per_cu); }
        (void)hipGetLastError();
        grid = cus;
    }
    if (grid < 0) return;
    (void)hipMemsetAsync((char*)d_ws + WS_CTL, 0, CTL_ZERO_BYTES, stream);
    Args a{};
    for (int i = 0; i < 26; ++i) a.in[i] = (const float*)d_in[i];
    a.out = (float*)d_out; a.ws = (unsigned char*)d_ws; a.chk = 0; a.pad = 0;
#if DBG
    (void)hipMemsetAsync((char*)d_ws + WS_DBG, 0, 4096, stream);
#define DBG_STEP(K) a.ph_lo = K; a.ph_hi = K + 1; hipLaunchKernelGGL(fwd_kernel, dim3(grid), dim3(NWAVES * 64), LDS_BYTES, stream, a); hipLaunchKernelGGL(check_kernel<K>, dim3(256), dim3(256), 0, stream, a);
    DBG_STEP(0) DBG_STEP(1) DBG_STEP(2) DBG_STEP(3) DBG_STEP(4) DBG_STEP(5) DBG_STEP(6) DBG_STEP(7) DBG_STEP(8) DBG_STEP(9) DBG_STEP(10) DBG_STEP(11) DBG_STEP(12)
    DBG_STEP(13) DBG_STEP(14) DBG_STEP(15) DBG_STEP(16) DBG_STEP(17) DBG_STEP(18) DBG_STEP(19) DBG_STEP(20) DBG_STEP(21) DBG_STEP(22) DBG_STEP(23) DBG_STEP(24)
    hipLaunchKernelGGL(dbg_sanitize, dim3(1024), dim3(256), 0, stream, a);
    hipLaunchKernelGGL(dbg_encode, dim3(1), dim3(64), 0, stream, a);
#elif ONE_LAUNCH
    a.ph_lo = 0; a.ph_hi = NPHASE;
    hipLaunchKernelGGL(fwd_kernel, dim3(grid), dim3(NWAVES * 64), LDS_BYTES, stream, a);
#else
    for (int k = 0; k < NPHASE; ++k) { a.ph_lo = k; a.ph_hi = k + 1; hipLaunchKernelGGL(fwd_kernel, dim3(grid), dim3(NWAVES * 64), LDS_BYTES, stream, a); }
#endif
}
```

```cpp
#define DBG 0
#define ONE_LAUNCH 1
#include <hip/hip_runtime.h>
#include <cstdio>
#include <cstdint>
#ifndef DBG
#define DBG 0
#endif
#ifndef ONE_LAUNCH
#define ONE_LAUNCH 1
#endif
#ifndef PG8_SP2
#define PG8_SP2 true
#endif
#ifndef PG8_ALIGN
#define PG8_ALIGN true
#endif
namespace pg8 {
#define PG8_LAS __attribute__((address_space(3)))
typedef unsigned short bf16_t;
typedef short bf16x8 __attribute__((ext_vector_type(8)));
typedef float f32x4 __attribute__((ext_vector_type(4)));
typedef unsigned u32x4 __attribute__((ext_vector_type(4)));
constexpr int BM = 256, BK = 64, HALF = 128, HTB = HALF * BK * 2  , STAGE_BYTES = 8 * HTB, NXCD = 8;
#ifndef PG8_WGM
#define PG8_WGM 8
#endif
constexpr int WGM = PG8_WGM;

__host__ __device__ __forceinline__ int lds_byte(int r, int c) { const int st = (r >> 4) * 2 + (c >> 5), rr = r & 15, cc = c & 31, ob = rr * 64 + cc * 2; return st * 1024 + (ob ^ (((ob >> 9) & 1) << 5)); }
__host__ __device__ __forceinline__ void stage_rc(int b, int& R, int& C) { const int st = b / 1024, sb = b % 1024, swz = sb ^ (((sb >> 9) & 1) << 5); R = (st >> 1) * 16 + swz / 64; C = (st & 1) * 32 + (swz % 64) / 2; }
__host__ __device__ __forceinline__ int perm32(int rho) { const int n = rho >> 4, i = rho & 15; return 8 * (i >> 2) + 4 * n + (i & 3); }

struct Unit { int pm, pn, k0, nt, sp, idx; };
struct Gemm { const bf16_t* A; const bf16_t* Bt; int M, N, K, lda, ldb; };

struct StaticOrder {
    int nM, nN, nwg, G, c, ntk, nmaj;
    __host__ __device__ void init(int M, int N, int G_, int c_, int K_, int nmaj_ = 0) { nM = M / BM; nN = N / BM; nwg = nM * nN; G = G_; c = c_; ntk = K_ / BK; nmaj = nmaj_; }
    __host__ __device__ __forceinline__ void map(int wgid, int& pm, int& pn) const {
        { const int q = nwg / NXCD, r = nwg % NXCD, xcd = wgid % NXCD, off = wgid / NXCD; wgid = (xcd < r ? xcd * (q + 1) : r * (q + 1) + (xcd - r) * q) + off; }
        if (nmaj > 0) { const int nig = nmaj * nM, gid = wgid / nig, fn = gid * nmaj, gsz = (nN - fn) < nmaj ? (nN - fn) : nmaj; pn = fn + ((wgid % nig) % gsz); pm = (wgid % nig) / gsz; return; }
        const int nig = WGM * nN, gid = wgid / nig, fm = gid * WGM, gsz = (nM - fm) < WGM ? (nM - fm) : WGM;
        pm = fm + ((wgid % nig) % gsz); pn = (wgid % nig) / gsz;
    }
    __host__ __device__ __forceinline__ bool next(int i, Unit& u) const {
        const long L = (long)i * G + c; if (L >= nwg) return false;
        int pm, pn; map((int)L, pm, pn); u.pm = pm; u.pn = pn; u.k0 = 0; u.nt = ntk; u.sp = -1; u.idx = i; return true;
    }
    __device__ __forceinline__ void a_ready(const Unit&) const {}
    __device__ __forceinline__ void done(const Unit&) const {}
};
__device__ __forceinline__ unsigned cvt_pk_bf16(float lo, float hi) { unsigned r; asm volatile("v_cvt_pk_bf16_f32 %0, %1, %2" : "=v"(r) : "v"(lo), "v"(hi)); return r; }
typedef float f32x2 __attribute__((ext_vector_type(2)));
template <class Epi, class Sched, bool ALIGN_EPI = false, bool SP2 = false>
__device__ __forceinline__ void gemm_phase(PG8_LAS unsigned char* lds, const Gemm g, const Sched& S, const Epi& E) {
    const int tid = threadIdx.x, wid = __builtin_amdgcn_readfirstlane(tid >> 6), lane = tid & 63, wr = wid >> 2, wc = wid & 3, fr = lane & 15, fq = lane >> 4;
    const int K = g.K;
    unsigned voffA[2], voffB[2];
#pragma unroll
    for (int i = 0; i < 2; ++i) { int R, C; stage_rc(tid * 16 + i * 8192, R, C); const int Rb = Epi::PERM ? ((R & ~31) + perm32(R & 31)) : R;
        voffA[i] = (unsigned)(R * g.lda + C) * 2u; voffB[i] = (unsigned)(Rb * (g.ldb ? g.ldb : BK) + C) * 2u; }
    const size_t kstepA = (size_t)(BK * 2), kstepB = g.ldb ? (size_t)(BK * 2) : (size_t)(BM * BK * 2);
    const size_t hstepA = (size_t)HALF * g.lda * 2, hstepB = g.ldb ? (size_t)HALF * g.ldb * 2 : (size_t)HALF * BK * 2;
    const size_t tstepA = 2 * hstepA, tstepB = g.ldb ? 2 * hstepB : (size_t)BM * K * 2;
    const unsigned ldsw = (unsigned)wid * 1024u;
    const int aoff = lds_byte(wr * 64 + fr, fq * 8), boff = lds_byte(wc * 32 + fr, fq * 8);
#define PG8_SA(b, h) (((b) * 2 + (h)) * HTB)
#define PG8_SB(b, h) ((4 + (b) * 2 + (h)) * HTB)
#define PG8_STAGE(bufoff, gbase, voff) do { _Pragma("unroll") for (int _i = 0; _i < 2; ++_i) \
        __builtin_amdgcn_global_load_lds((const unsigned*)((const char*)(gbase) + (voff)[_i]), (PG8_LAS unsigned*)(lds + (bufoff) + ldsw + _i * 8192), 16, 0, 0); } while (0)
#define PG8_LDA(dst, b, h) do { _Pragma("unroll") for (int m = 0; m < 4; ++m) _Pragma("unroll") for (int k = 0; k < 2; ++k) dst[m][k] = *(const PG8_LAS bf16x8*)(lds + PG8_SA(b, h) + aoff + m * 2048 + k * 1024); } while (0)
#define PG8_LDB(dst, b, h) do { _Pragma("unroll") for (int n = 0; n < 2; ++n) _Pragma("unroll") for (int k = 0; k < 2; ++k) dst[n][k] = *(const PG8_LAS bf16x8*)(lds + PG8_SB(b, h) + boff + n * 2048 + k * 1024); } while (0)
#define PG8_MMA(ai, bj, At, Bt) do { __builtin_amdgcn_s_setprio(1); _Pragma("unroll") for (int m = 0; m < 4; ++m) _Pragma("unroll") for (int n = 0; n < 2; ++n) _Pragma("unroll") for (int k = 0; k < 2; ++k) \
        acc[ai][bj][m][n] = __builtin_amdgcn_mfma_f32_16x16x32_bf16(Bt[n][k], At[m][k], acc[ai][bj][m][n], 0, 0, 0); __builtin_amdgcn_s_setprio(0); } while (0)
#define PG8_WAIT_V(n) asm volatile("s_waitcnt vmcnt(" #n ")" ::: "memory")
#define PG8_WAIT_L(n) asm volatile("s_waitcnt lgkmcnt(" #n ")" ::: "memory")
#define PG8_BAR __builtin_amdgcn_s_barrier()
#define PG8_SCHED __builtin_amdgcn_sched_barrier(0)
    Unit cur, nxt; int ui = 0;
    if (!S.next(0, cur)) return;
    f32x4 acc[2][2][4][2];
#pragma unroll
    for (int a = 0; a < 2; ++a)
#pragma unroll
        for (int b = 0; b < 2; ++b)
#pragma unroll
            for (int m = 0; m < 4; ++m)
#pragma unroll
                for (int n = 0; n < 2; ++n) acc[a][b][m][n] = (f32x4){0.f, 0.f, 0.f, 0.f};
    bf16x8 At[4][2], B0[2][2], B1[2][2];
    const char* cA = (const char*)g.A + (size_t)cur.pm * tstepA + (size_t)cur.k0 * kstepA; const char* cB = (const char*)g.Bt + (size_t)cur.pn * tstepB + (size_t)cur.k0 * kstepB;
    S.a_ready(cur);
    if constexpr (SP2) {
        PG8_STAGE(PG8_SB(0, 0), cB, voffB); PG8_STAGE(PG8_SB(0, 1), cB + hstepB, voffB); PG8_STAGE(PG8_SA(0, 0), cA, voffA); PG8_STAGE(PG8_SA(0, 1), cA + hstepA, voffA);
        if (wr == 1) PG8_BAR;
        PG8_WAIT_V(2); PG8_BAR;
        PG8_STAGE(PG8_SB(1, 0), cB + kstepB, voffB); PG8_STAGE(PG8_SA(1, 0), cA + kstepA, voffA); PG8_STAGE(PG8_SB(1, 1), cB + hstepB + kstepB, voffB);
        PG8_WAIT_V(6); PG8_BAR;
    } else {
        PG8_STAGE(PG8_SB(0, 0), cB, voffB); PG8_STAGE(PG8_SA(0, 0), cA, voffA); PG8_STAGE(PG8_SB(0, 1), cB + hstepB, voffB); PG8_STAGE(PG8_SA(0, 1), cA + hstepA, voffA);
        if (wr == 1) PG8_BAR;
        PG8_WAIT_V(4); PG8_BAR;
        PG8_STAGE(PG8_SB(1, 0), cB + kstepB, voffB); PG8_STAGE(PG8_SA(1, 0), cA + kstepA, voffA); PG8_STAGE(PG8_SB(1, 1), cB + hstepB + kstepB, voffB);
        PG8_WAIT_V(6); PG8_BAR;
    }
    for (;;) {
        const bool has_next = S.next(ui + 1, nxt);
        const char* nA = has_next ? (const char*)g.A + (size_t)nxt.pm * tstepA + (size_t)nxt.k0 * kstepA : cA; const char* nB = has_next ? (const char*)g.Bt + (size_t)nxt.pn * tstepB + (size_t)nxt.k0 * kstepB : cB;
        const int nt = cur.nt;
        for (int t = 0; t < nt; t += 2) {
            const bool last = (t == nt - 2);
            const char* a1 = cA + (size_t)(t + 1) * kstepA;
            const char* a2 = last ? nA : cA + (size_t)(t + 2) * kstepA; const char* b2 = last ? nB : cB + (size_t)(t + 2) * kstepB;
            const char* a3 = a2 + kstepA; const char* b3 = b2 + kstepB;
            if (last && has_next) S.a_ready(nxt);
            if constexpr (SP2) {
            PG8_LDB(B0, 0, 0); PG8_LDB(B1, 0, 1); PG8_SCHED; PG8_LDA(At, 0, 0); PG8_STAGE(PG8_SA(1, 1), a1 + hstepA, voffA);
            PG8_WAIT_V(8); PG8_WAIT_L(0); PG8_BAR; PG8_MMA(0, 0, At, B0); PG8_MMA(0, 1, At, B1); PG8_BAR; PG8_SCHED;
            PG8_LDA(At, 0, 1); PG8_STAGE(PG8_SB(0, 0), b2, voffB); PG8_STAGE(PG8_SB(0, 1), b2 + hstepB, voffB); PG8_STAGE(PG8_SA(0, 0), a2, voffA);
            PG8_WAIT_V(8); PG8_WAIT_L(0); PG8_BAR; PG8_MMA(1, 0, At, B0); PG8_MMA(1, 1, At, B1); PG8_BAR; PG8_SCHED;
            PG8_LDB(B0, 1, 0); PG8_LDB(B1, 1, 1); PG8_SCHED; PG8_LDA(At, 1, 0); PG8_STAGE(PG8_SA(0, 1), a2 + hstepA, voffA);
            PG8_WAIT_V(8); PG8_WAIT_L(0); PG8_BAR; PG8_MMA(0, 0, At, B0); PG8_MMA(0, 1, At, B1); PG8_BAR; PG8_SCHED;
            PG8_LDA(At, 1, 1); PG8_STAGE(PG8_SB(1, 0), b3, voffB); PG8_STAGE(PG8_SB(1, 1), b3 + hstepB, voffB); PG8_STAGE(PG8_SA(1, 0), a3, voffA);
            PG8_WAIT_V(8); PG8_WAIT_L(0); PG8_BAR; PG8_MMA(1, 0, At, B0); PG8_MMA(1, 1, At, B1); PG8_BAR; PG8_SCHED;
            } else {
            PG8_LDB(B0, 0, 0); PG8_SCHED; PG8_LDA(At, 0, 0); PG8_STAGE(PG8_SA(1, 1), a1 + hstepA, voffA);
            PG8_WAIT_L(8); PG8_BAR; PG8_WAIT_L(0); PG8_MMA(0, 0, At, B0); PG8_BAR; PG8_SCHED;
            PG8_LDB(B1, 0, 1); PG8_STAGE(PG8_SB(0, 0), b2, voffB);
            PG8_BAR; PG8_WAIT_L(0); PG8_MMA(0, 1, At, B1); PG8_BAR;
            PG8_LDA(At, 0, 1); PG8_STAGE(PG8_SA(0, 0), a2, voffA);
            PG8_BAR; PG8_WAIT_L(0); PG8_MMA(1, 0, At, B0); PG8_BAR; PG8_SCHED;
            PG8_STAGE(PG8_SB(0, 1), b2 + hstepB, voffB);
            PG8_WAIT_V(6); PG8_BAR; PG8_MMA(1, 1, At, B1); PG8_BAR;
            PG8_LDB(B0, 1, 0); PG8_SCHED; PG8_LDA(At, 1, 0); PG8_STAGE(PG8_SA(0, 1), a2 + hstepA, voffA);
            PG8_WAIT_L(8); PG8_BAR; PG8_WAIT_L(0); PG8_MMA(0, 0, At, B0); PG8_BAR; PG8_SCHED;
            PG8_LDB(B1, 1, 1); PG8_STAGE(PG8_SB(1, 0), b3, voffB);
            PG8_BAR; PG8_WAIT_L(0); PG8_MMA(0, 1, At, B1); PG8_BAR;
            PG8_LDA(At, 1, 1); PG8_STAGE(PG8_SA(1, 0), a3, voffA);
            PG8_BAR; PG8_WAIT_L(0); PG8_MMA(1, 0, At, B0); PG8_BAR; PG8_SCHED;
            PG8_STAGE(PG8_SB(1, 1), b3 + hstepB, voffB);
            PG8_WAIT_V(6); PG8_BAR; PG8_MMA(1, 1, At, B1); PG8_BAR;
            }
        }
        if constexpr (ALIGN_EPI) { if (wr == 0) PG8_BAR; }
        if constexpr (!Epi::AFTER_DRAIN) { E(acc, cur, wr, wc, fr, fq); S.done(cur); }
        if (!has_next) break;
#pragma unroll
        for (int a = 0; a < 2; ++a)
#pragma unroll
            for (int b = 0; b < 2; ++b)
#pragma unroll
                for (int m = 0; m < 4; ++m)
#pragma unroll
                    for (int n = 0; n < 2; ++n) acc[a][b][m][n] = (f32x4){0.f, 0.f, 0.f, 0.f};
        cur = nxt; cA = nA; cB = nB; ++ui;
        if constexpr (ALIGN_EPI) { if (wr == 1) PG8_BAR; }
    }
    PG8_WAIT_V(0);
    if constexpr (!ALIGN_EPI) { if (wr == 0) PG8_BAR; }
    PG8_BAR;
    if constexpr (Epi::AFTER_DRAIN) { E.fused(acc, cur, wr, wc, fr, fq, lds, wid, lane); S.done(cur); }
#undef PG8_SA
#undef PG8_SB
#undef PG8_STAGE
#undef PG8_LDA
#undef PG8_LDB
#undef PG8_MMA
#undef PG8_WAIT_V
#undef PG8_WAIT_L
#undef PG8_BAR
#undef PG8_SCHED
}
struct EpiBf16P {
    static constexpr bool PERM = true, AFTER_DRAIN = false;
    bf16_t* O; int ldc;
    __device__ __forceinline__ void operator()(const f32x4 (&acc)[2][2][4][2], const Unit& u, int wr, int wc, int fr, int fq) const {
        const int row0 = u.pm * BM + wr * 64 + fr, col0 = u.pn * BM + wc * 32 + 8 * fq;
#pragma unroll
        for (int ai = 0; ai < 2; ++ai)
#pragma unroll
            for (int m = 0; m < 4; ++m) { bf16_t* rowp = O + (size_t)(row0 + ai * HALF + m * 16) * ldc + col0;
#pragma unroll
                for (int bj = 0; bj < 2; ++bj) { const f32x4 v0 = acc[ai][bj][m][0], v1 = acc[ai][bj][m][1];
                    u32x4 w; w.x = cvt_pk_bf16(v0[0], v0[1]); w.y = cvt_pk_bf16(v0[2], v0[3]); w.z = cvt_pk_bf16(v1[0], v1[1]); w.w = cvt_pk_bf16(v1[2], v1[3]);
                    *(u32x4*)(rowp + bj * HALF) = w; } }
    }
};
struct EpiF32P {
    static constexpr bool PERM = false, AFTER_DRAIN = false;
    float* C; int ldc;
    __device__ __forceinline__ void operator()(const f32x4 (&acc)[2][2][4][2], const Unit& u, int wr, int wc, int fr, int fq) const {
        const int row0 = u.pm * BM + wr * 64 + fr, col0 = u.pn * BM + wc * 32 + 4 * fq;
#pragma unroll
        for (int ai = 0; ai < 2; ++ai)
#pragma unroll
            for (int m = 0; m < 4; ++m) { float* rowp = C + (size_t)(row0 + ai * HALF + m * 16) * ldc + col0;
#pragma unroll
                for (int bj = 0; bj < 2; ++bj)
#pragma unroll
                    for (int n = 0; n < 2; ++n) *(f32x4*)(rowp + bj * HALF + n * 16) = acc[ai][bj][m][n]; }
    }
};
__device__ __forceinline__ float silu_mul(float g, float u) { const float e = __builtin_amdgcn_exp2f(g * -1.4426950408889634f); return g * __builtin_amdgcn_rcpf(1.0f + e) * u; }
struct EpiSwiglu {
    static constexpr bool PERM = true, AFTER_DRAIN = false;
    bf16_t* O; int ldc;
    __device__ __forceinline__ void operator()(const f32x4 (&acc)[2][2][4][2], const Unit& u, int wr, int wc, int fr, int fq) const {
        const int row0 = u.pm * BM + wr * 64 + fr, col0 = u.pn * HALF + wc * 32 + 8 * fq;
#pragma unroll
        for (int ai = 0; ai < 2; ++ai)
#pragma unroll
            for (int m = 0; m < 4; ++m) { bf16_t* rowp = O + (size_t)(row0 + ai * HALF + m * 16) * ldc + col0;
                const f32x4 g0 = acc[ai][0][m][0], g1 = acc[ai][0][m][1], u0 = acc[ai][1][m][0], u1 = acc[ai][1][m][1];
                u32x4 w; w.x = cvt_pk_bf16(silu_mul(g0[0], u0[0]), silu_mul(g0[1], u0[1])); w.y = cvt_pk_bf16(silu_mul(g0[2], u0[2]), silu_mul(g0[3], u0[3]));
                w.z = cvt_pk_bf16(silu_mul(g1[0], u1[0]), silu_mul(g1[1], u1[1])); w.w = cvt_pk_bf16(silu_mul(g1[2], u1[2]), silu_mul(g1[3], u1[3]));
                *(u32x4*)rowp = w; }
    }
};
struct EpiResid {
    static constexpr bool PERM = false, AFTER_DRAIN = false;
    const float* res_lat; const float* res_ctx; float* out; const float* gate; float gs;
    __device__ __forceinline__ void operator()(const f32x4 (&acc)[2][2][4][2], const Unit& u, int wr, int wc, int fr, int fq) const {
        const int rt = wr * 64 + fr, col0 = u.pn * BM + wc * 32 + 4 * fq;
        const int vec = u.pm < 16 ? 0 : (u.pm < 32 ? 1 : 2);
        const float* rbase = (u.pm < 32 ? res_lat + (size_t)u.pm * BM * 4096 : res_ctx + (size_t)(u.pm - 32) * BM * 4096) + col0;
        float* obase = out + (size_t)u.pm * BM * 4096 + col0;
        const float* gp = gate + (size_t)vec * 9 * 4096 + col0;
        f32x4 gv[2][2];
#pragma unroll
        for (int bj = 0; bj < 2; ++bj)
#pragma unroll
            for (int n = 0; n < 2; ++n) gv[bj][n] = *(const f32x4*)(gp + bj * HALF + n * 16) * gs;
#pragma unroll
        for (int ai = 0; ai < 2; ++ai)
#pragma unroll
            for (int mp = 0; mp < 4; mp += 2) {
                f32x4 r[2][2][2];
#pragma unroll
                for (int m = 0; m < 2; ++m) { const size_t ro = (size_t)(rt + ai * HALF + (mp + m) * 16) * 4096;
#pragma unroll
                    for (int bj = 0; bj < 2; ++bj)
#pragma unroll
                        for (int n = 0; n < 2; ++n) r[m][bj][n] = *(const f32x4*)(rbase + ro + bj * HALF + n * 16); }
                __builtin_amdgcn_sched_barrier(0);
#pragma unroll
                for (int m = 0; m < 2; ++m) { const size_t ro = (size_t)(rt + ai * HALF + (mp + m) * 16) * 4096;
#pragma unroll
                    for (int bj = 0; bj < 2; ++bj)
#pragma unroll
                        for (int n = 0; n < 2; ++n) *(f32x4*)(obase + ro + bj * HALF + n * 16) = r[m][bj][n] + gv[bj][n] * acc[ai][bj][mp + m][n]; }
                __builtin_amdgcn_sched_barrier(0);
                asm volatile("" ::: "memory"); }
    }
};

struct SplitOrder {
    StaticOrder lat; int G, c, ntk;
    __host__ __device__ void init(int G_, int c_, int K_) { lat.init(8192, 4096, G_, c_, K_); G = G_; c = c_; ntk = K_ / BK; }
    __host__ __device__ __forceinline__ bool next(int i, Unit& u) const {
        const long L = (long)i * G + c; if (L >= 768) return false;
        const bool isl = L < 512; int pm, pn; lat.map(isl ? (int)L : 0, pm, pn);
        const int j = (int)(L - 512) & 255, sp = j & 7, tile = j >> 3, ntq = ntk / 8;
        u.pm = isl ? pm : 32 + (tile >> 4); u.pn = isl ? pn : (tile & 15); u.k0 = isl ? 0 : sp * ntq; u.nt = isl ? ntk : ntq; u.sp = isl ? -1 : sp; u.idx = i; return true;
    }
    __device__ __forceinline__ void a_ready(const Unit&) const {}
    __device__ __forceinline__ void done(const Unit&) const {}
};
struct EpiResidSplit {
    static constexpr bool PERM = false, AFTER_DRAIN = false;
    EpiResid r; float* slab;
    __device__ __forceinline__ void operator()(const f32x4 (&acc)[2][2][4][2], const Unit& u, int wr, int wc, int fr, int fq) const {
        if (u.sp < 0) { r(acc, u, wr, wc, fr, fq); return; }
        const int row0 = (u.pm - 32) * BM + wr * 64 + fr, col0 = u.pn * BM + wc * 32 + 4 * fq;
        float* base = slab + ((size_t)u.sp * 512 + row0) * 4096 + col0;
#pragma unroll
        for (int ai = 0; ai < 2; ++ai)
#pragma unroll
            for (int m = 0; m < 4; ++m) { float* rowp = base + (size_t)(ai * HALF + m * 16) * 4096;
#pragma unroll
                for (int bj = 0; bj < 2; ++bj)
#pragma unroll
                    for (int n = 0; n < 2; ++n) *(f32x4*)(rowp + bj * HALF + n * 16) = acc[ai][bj][m][n]; }
    }
};

}
namespace att {
#define ATT_LAS __attribute__((address_space(3)))
typedef unsigned short bf16;
using bf16x8 = __attribute__((ext_vector_type(8))) short;
using s16x4  = __attribute__((ext_vector_type(4))) short;
using f32x16 = __attribute__((ext_vector_type(16))) float;
using u32x4  = __attribute__((ext_vector_type(4))) unsigned;
constexpr int NW = 8, QBLK = 32, KVBLK = 64, DV = 128;
constexpr float THR = 8.f;
#define ATT_SBAR() __builtin_amdgcn_sched_barrier(0)
__device__ __forceinline__ int crow(int r, int hi) { return (r & 3) + 8 * (r >> 2) + 4 * hi; }
__device__ __forceinline__ unsigned cvtpk(float lo, float hi) { unsigned r; asm volatile("v_cvt_pk_bf16_f32 %0, %1, %2" : "=v"(r) : "v"(lo), "v"(hi)); return r; }
typedef unsigned rawx4 __attribute__((ext_vector_type(4)));
__device__ __forceinline__ __amdgpu_buffer_rsrc_t mk_rsrc(const void* p) {
  const unsigned long long a = (unsigned long long)p; const unsigned lo = __builtin_amdgcn_readfirstlane((unsigned)a), hi = __builtin_amdgcn_readfirstlane((unsigned)(a >> 32));
  return __builtin_amdgcn_make_buffer_rsrc((void*)(((unsigned long long)hi << 32) | lo), 0, 0x7ffffffc, 0x00020000);
}
__device__ __forceinline__ bf16x8 ld16(__amdgpu_buffer_rsrc_t r, int voff, int soff) { const rawx4 v = __builtin_amdgcn_raw_buffer_load_b128(r, voff, soff, 0); return *reinterpret_cast<const bf16x8*>(&v); }
template <int DK> __device__ __forceinline__ int kswz(int row) { return DK == 192 ? ((row >> 1) & 7) : (row & 7); }
template <int DK> struct Cfg { static constexpr float SCALE = DK == 128 ? 0.088388347648318440f : 0.072168783648703220f;
    static constexpr int SHM_V = KVBLK * DV * 2, SHM_K = KVBLK * DK * 2, SHM_WS = 2 * SHM_V + 2 * SHM_K, SHM_RPB = SHM_WS + NW * 64 * 4, SHM_QR = SHM_RPB + 2048, SHM_END = SHM_QR;
    static constexpr int NQR = DK / 16;
    static constexpr int NKP = DK / 64;     static constexpr int SDEPTH = DK == 128 ? 2 : 1; };

template <int DK> __device__ __forceinline__ void partialSM(f32x16& p0, f32x16& p1, float& m_reg, float& mn, float& alpha) {
  constexpr float SCALE = Cfg<DK>::SCALE, C = SCALE * 1.4426950408889634f;
  float pmax = p0[0];
#pragma unroll
  for (int r = 1; r < 16; ++r) pmax = fmaxf(pmax, p0[r]);
#pragma unroll
  for (int r = 0; r < 16; ++r) pmax = fmaxf(pmax, p1[r]);
  { auto rr = __builtin_amdgcn_permlane32_swap(__float_as_uint(pmax), __float_as_uint(pmax), false, false);
    pmax = fmaxf(__uint_as_float(rr[0]), __uint_as_float(rr[1])); }
  if (__builtin_expect(__all(pmax - m_reg <= THR / SCALE), 1)) { mn = m_reg; alpha = 1.f; }
  else { mn = fmaxf(m_reg, pmax); alpha = __builtin_amdgcn_exp2f((m_reg - mn) * C); m_reg = mn; }
  const float mnC = -mn * C;
#pragma unroll
  for (int r = 0; r < 16; ++r) p0[r] = fmaf(p0[r], C, mnC);
#pragma unroll
  for (int r = 0; r < 16; ++r) p1[r] = fmaf(p1[r], C, mnC);
#pragma unroll
  for (int r = 0; r < 16; ++r) p0[r] = __builtin_amdgcn_exp2f(p0[r]);
}
__device__ __forceinline__ void finishSM(f32x16& p0, f32x16& p1, float alpha, float& l_reg, bf16x8& pa0, bf16x8& pa1, bf16x8& pa2, bf16x8& pa3) {
#pragma unroll
  for (int r = 0; r < 16; ++r) p1[r] = __builtin_amdgcn_exp2f(p1[r]);
  float ps = 0;
#pragma unroll
  for (int r = 0; r < 16; ++r) ps += p0[r];
#pragma unroll
  for (int r = 0; r < 16; ++r) ps += p1[r];
  { auto rr = __builtin_amdgcn_permlane32_swap(__float_as_uint(ps), __float_as_uint(ps), false, false);
    ps = __uint_as_float(rr[0]) + __uint_as_float(rr[1]); }
  l_reg = l_reg * alpha + ps;
#define ATT_PK4(P, BASE, OUT) do { unsigned a0 = cvtpk(P[BASE + 0], P[BASE + 1]), a1 = cvtpk(P[BASE + 2], P[BASE + 3]);   \
    unsigned b0 = cvtpk(P[BASE + 4], P[BASE + 5]), b1 = cvtpk(P[BASE + 6], P[BASE + 7]);                              \
    auto r0 = __builtin_amdgcn_permlane32_swap(a0, b0, false, false); auto r1 = __builtin_amdgcn_permlane32_swap(a1, b1, false, false); \
    u32x4 w = {r0[0], r1[0], r0[1], r1[1]}; OUT = *reinterpret_cast<bf16x8*>(&w); } while (0)
  ATT_PK4(p0, 0, pa0); ATT_PK4(p0, 8, pa1); ATT_PK4(p1, 0, pa2); ATT_PK4(p1, 8, pa3);
#undef ATT_PK4
}
struct NaWave { int na;
                int r0w;
                int rq;
                int cq, c0;
                int rlo;
                const ATT_LAS float* rpb; };
#define ATT_KRD(dst, d0, half) asm volatile("ds_read_b128 %0, %1 offset:%2" : "=v"(dst) : "v"(ksb + kx[(d0) & 3]), "n"(((d0) >> 2) * 128 + (half) * 32 * (DK * 2)) : "memory")
template <int DK> __device__ __forceinline__ void qkt_pre(bf16x8& fa, bf16x8& fb, int ksb, const int (&kx)[4]) { ATT_KRD(fa, 0, 0); ATT_KRD(fb, 0, 1); }
template <int DK, bool NA> __device__ __forceinline__ void qkt(f32x16& p0, f32x16& p1, bf16x8 fa, bf16x8 fb, int ksb, const bf16x8* qr, const char* qlds, const int (&kx)[4], int hi, const NaWave& nw, int tile) {
  p0 = f32x16{}; p1 = f32x16{};
  if constexpr (NA) {
    if (nw.na && tile >= 4) {
      const int kr = nw.rlo + (tile - 4);
      if (kr >= nw.r0w && kr < nw.r0w + 8) {
        const int base = (kr - nw.rq + 7) * 31 - nw.cq + 15;
#pragma unroll
        for (int r = 0; r < 16; ++r) { const int ck = crow(r, hi); const bool ok0 = (unsigned)(ck - nw.c0) < 16u, ok1 = (unsigned)(ck + 32 - nw.c0) < 16u;
          const float b0 = nw.rpb[ok0 ? base + ck : 0], b1 = nw.rpb[ok1 ? base + ck + 32 : 0];
          p0[r] = ok0 ? b0 : -1e30f; p1[r] = ok1 ? b1 : -1e30f; }
      } else {
#pragma unroll
        for (int r = 0; r < 16; ++r) { p0[r] = -1e30f; p1[r] = -1e30f; }
      }
    }
  }
  constexpr int ND = DK / 16;
  bf16x8 f[3][2]; f[0][0] = fa; f[0][1] = fb;
  ATT_KRD(f[1][0], 1, 0); ATT_KRD(f[1][1], 1, 1);
#pragma unroll
  for (int d0 = 0; d0 < ND; ++d0) {
    if (d0 + 2 < ND) { ATT_KRD(f[(d0 + 2) % 3][0], d0 + 2, 0); ATT_KRD(f[(d0 + 2) % 3][1], d0 + 2, 1); }
    asm volatile("s_waitcnt lgkmcnt(%2)" : "+v"(f[d0 % 3][0]), "+v"(f[d0 % 3][1]) : "n"(d0 + 2 < ND ? 4 : (d0 + 1 < ND ? 2 : 0)) : "memory");
    bf16x8 qf; if (d0 < Cfg<DK>::NQR) qf = qr[d0 < Cfg<DK>::NQR ? d0 : 0]; else qf = *reinterpret_cast<const bf16x8*>(qlds + (d0 - Cfg<DK>::NQR) * 1024);
    p0 = __builtin_amdgcn_mfma_f32_32x32x16_bf16(f[d0 % 3][0], qf, p0, 0, 0, 0);
    p1 = __builtin_amdgcn_mfma_f32_32x32x16_bf16(f[d0 % 3][1], qf, p1, 0, 0, 0); }
}
#undef ATT_KRD
__device__ __forceinline__ int v_st(int k, int c) { const int kk = (k & ~0xC) | ((k & 4) << 1) | ((k & 8) >> 1); return ((kk >> 3) * 4 + (c >> 5)) * 512 + ((kk & 7) * 32 + (c & 31)) * 2; }
__device__ __forceinline__ int v_rd_base(int lane) { return ((lane & 3) << 3) | (((lane >> 2) & 3) << 6) | (((lane >> 4) & 1) << 5) | (((lane >> 5) & 1) << 8); }
constexpr int v_rd_off(int d0, int ks, int half) { return d0 * 512 + ks * 4096 + half * 2048; }
template <int OFF> __device__ __forceinline__ s16x4 tr_read(int vb) {
  s16x4 r; asm volatile("ds_read_b64_tr_b16 %0, %1 offset:%2" : "=&v"(r) : "v"(vb), "i"(OFF) : "memory"); return r;
}
struct VHalf { s16x4 la, ha, lb, hb; };
template <int HB> __device__ __forceinline__ void pv_read(VHalf& f, int vb) {
  constexpr int D0 = HB >> 1, K0 = 2 * (HB & 1);
  f.la = tr_read<v_rd_off(D0, K0, 0)>(vb); f.ha = tr_read<v_rd_off(D0, K0, 1)>(vb); f.lb = tr_read<v_rd_off(D0, K0 + 1, 0)>(vb); f.hb = tr_read<v_rd_off(D0, K0 + 1, 1)>(vb);
}
__device__ __forceinline__ void pv_mma(f32x16& od, const VHalf& f, bf16x8 pa, bf16x8 pb) {
#define ATT_PK(L, H) (bf16x8){L[0], L[1], L[2], L[3], H[0], H[1], H[2], H[3]}
  od = __builtin_amdgcn_mfma_f32_32x32x16_bf16(pa, ATT_PK(f.la, f.ha), od, 0, 0, 0);
  od = __builtin_amdgcn_mfma_f32_32x32x16_bf16(pb, ATT_PK(f.lb, f.hb), od, 0, 0, 0);
#undef ATT_PK
}
__device__ __forceinline__ void pv_d0(f32x16* o, int vb, bf16x8 pa0, bf16x8 pa1, bf16x8 pa2, bf16x8 pa3) {
  VHalf f0, f1, f2;
#define ATT_PVW(n) do { asm volatile("s_waitcnt lgkmcnt(" #n ")" ::: "memory"); ATT_SBAR(); } while (0)
  pv_read<0>(f0, vb); pv_read<1>(f1, vb);
  pv_read<2>(f2, vb); ATT_PVW(8); pv_mma(o[0], f0, pa0, pa1); ATT_SBAR();
  pv_read<3>(f0, vb); ATT_PVW(8); pv_mma(o[0], f1, pa2, pa3); ATT_SBAR();
  pv_read<4>(f1, vb); ATT_PVW(8); pv_mma(o[1], f2, pa0, pa1); ATT_SBAR();
  pv_read<5>(f2, vb); ATT_PVW(8); pv_mma(o[1], f0, pa2, pa3); ATT_SBAR();
  pv_read<6>(f0, vb); ATT_PVW(8); pv_mma(o[2], f1, pa0, pa1); ATT_SBAR();
  pv_read<7>(f1, vb); ATT_PVW(8); pv_mma(o[2], f2, pa2, pa3); ATT_SBAR();
  ATT_PVW(4); pv_mma(o[3], f0, pa0, pa1); ATT_SBAR();
  ATT_PVW(0); pv_mma(o[3], f1, pa2, pa3);
#undef ATT_PVW
}

template <int DK, bool NA, class Side>
__device__ __forceinline__ void attn_body(const bf16* __restrict__ Qb, int ldq, const bf16* __restrict__ Kh, int ldk, const bf16* __restrict__ Vh, int ldv,
                                          bf16* __restrict__ Ob, int ldo, int NT, int seg2, int vr_ctx, int vr_lat, const NaWave& nw, char* lds, Side& sd) {
  using C_ = Cfg<DK>; constexpr int SHM_V = C_::SHM_V, SHM_K = C_::SHM_K, NKP = C_::NKP;
  int tid = threadIdx.x; asm volatile("" : "+v"(tid));
  const int wid = tid >> 6, lane = tid & 63, r32 = lane & 31, hi = lane >> 5;
  char* V_lds = lds; char* K_lds = lds + 2 * SHM_V;
  float* wsf = (float*)(lds + C_::SHM_WS) + wid * 64; float* li_l = wsf; float* al_l = wsf + 32;
  float m_reg = -1e30f, l_reg = 0; f32x16 o[4] = {}; bf16x8 qr[C_::NQR]; char* qlds = nullptr;
  __syncthreads();
  const bf16* Qw = Qb + (long)(wid * QBLK + r32) * ldq + hi * 8;
#pragma unroll
  for (int d0 = 0; d0 < DK / 16; ++d0) { const bf16x8 qv = *reinterpret_cast<const bf16x8*>(Qw + d0 * 16); if (d0 < C_::NQR) qr[d0 < C_::NQR ? d0 : 0] = qv; else *reinterpret_cast<bf16x8*>(qlds + (d0 - C_::NQR) * 1024) = qv; }
  const int sr = tid >> 4, sc = (tid & 15) * 8, vst0 = v_st(sr, sc), vst1 = vst0 + 8192;
  const __amdgpu_buffer_rsrc_t krs = mk_rsrc(Kh), vrs = mk_rsrc(Vh); const int vgo0 = (sr * ldv + sc) * 2, ldk2 = __builtin_amdgcn_readfirstlane(ldk * 2), ldv2 = __builtin_amdgcn_readfirstlane(ldv * 2);
  const int kgo0 = ((tid >> 3) * ldk + (tid & 7) * 8) * 2, klo0 = (tid >> 3) * (DK * 2) + (((tid & 7) * 16) ^ (kswz<DK>(tid >> 3) << 4));
  const int vb0 = (int)(uintptr_t)V_lds + v_rd_base(lane);
  int kx[4];
#pragma unroll
  for (int dl = 0; dl < 4; ++dl) kx[dl] = r32 * (DK * 2) + ((dl * 32 + hi * 16) ^ (kswz<DK>(r32) << 4));
  bf16x8 vs0, vs1, ks[NKP];
#define ATT_KOFF(t) ((t) * KVBLK + ((NA && (t) >= 4) ? seg2 : 0))
#define ATT_VOFF(t) (((t) < 4 ? vr_ctx : vr_lat) + (t) * KVBLK + ((NA && (t) >= 4) ? seg2 : 0))
#define ATT_SLOAD(t) do { const int k0_ = __builtin_amdgcn_readfirstlane(ATT_KOFF(t)); vs0 = ld16(vrs, vgo0, k0_ * ldv2); vs1 = ld16(vrs, vgo0, (k0_ + 32) * ldv2); \
    _Pragma("unroll") for (int q_ = 0; q_ < NKP; ++q_) ks[q_] = ld16(krs, kgo0 + 128 * q_, k0_ * ldk2); } while (0)
#define ATT_SWRITE(b) do { *(bf16x8*)(V_lds + (b) * SHM_V + vst0) = vs0; *(bf16x8*)(V_lds + (b) * SHM_V + vst1) = vs1; \
    _Pragma("unroll") for (int q_ = 0; q_ < NKP; ++q_) *(bf16x8*)(K_lds + (b) * SHM_K + klo0 + 128 * q_) = ks[q_]; } while (0)
  const int vla = (int)(uintptr_t)V_lds + vst0, kla = (int)(uintptr_t)K_lds + klo0;
  typedef unsigned srd_t __attribute__((ext_vector_type(4)));
  srd_t ksrd, vsrd;
  { const unsigned long long ka_ = (unsigned long long)Kh, va_ = (unsigned long long)Vh;
    ksrd = (srd_t){(unsigned)__builtin_amdgcn_readfirstlane((unsigned)ka_), (unsigned)__builtin_amdgcn_readfirstlane((unsigned)(ka_ >> 32)), 0x7ffffffcu, 0x00020000u};
    vsrd = (srd_t){(unsigned)__builtin_amdgcn_readfirstlane((unsigned)va_), (unsigned)__builtin_amdgcn_readfirstlane((unsigned)(va_ >> 32)), 0x7ffffffcu, 0x00020000u}; }
#define ATT_BLD(dst, srd, voff, soff, imm) asm volatile("buffer_load_dwordx4 %0, %1, %2, %3 offen offset:%4" : "=v"(dst) : "v"(voff), "s"(srd), "s"(soff), "n"(imm) : "memory")
#define ATT_SLOAD_ASM(t) do { const int k0_ = __builtin_amdgcn_readfirstlane(ATT_KOFF(t)); const int sv0_ = __builtin_amdgcn_readfirstlane(k0_ * ldv2), sv1_ = __builtin_amdgcn_readfirstlane((k0_ + 32) * ldv2), sk_ = __builtin_amdgcn_readfirstlane(k0_ * ldk2); \
    ATT_BLD(vs0, vsrd, vgo0, sv0_, 0); ATT_BLD(vs1, vsrd, vgo0, sv1_, 0); _Pragma("unroll") for (int q_ = 0; q_ < NKP; ++q_) ATT_BLD(ks[q_], ksrd, kgo0, sk_, 128 * q_); } while (0)
#define ATT_DSW(addr, off, val) asm volatile("ds_write_b128 %0, %1 offset:%2" :: "v"(addr), "v"(val), "n"(off) : "memory")
#define ATT_SWRITE_ASM(b) do { const int va_ = vla + (b) * SHM_V, ka_ = kla + (b) * SHM_K; ATT_DSW(va_, 0, vs0); ATT_DSW(va_, 8192, vs1); \
    _Pragma("unroll") for (int q_ = 0; q_ < NKP; ++q_) ATT_DSW(ka_, 128 * q_, ks[q_]); } while (0)
#define ATT_VLOAD_ASM(t) do { const int k0_ = __builtin_amdgcn_readfirstlane(ATT_VOFF(t)); const int sv0_ = __builtin_amdgcn_readfirstlane(k0_ * ldv2), sv1_ = __builtin_amdgcn_readfirstlane((k0_ + 32) * ldv2); \
    ATT_BLD(vs0, vsrd, vgo0, sv0_, 0); ATT_BLD(vs1, vsrd, vgo0, sv1_, 0); } while (0)
#define ATT_KLOAD_ASM(t) do { const int k0_ = __builtin_amdgcn_readfirstlane(ATT_KOFF(t)); const int sk_ = __builtin_amdgcn_readfirstlane(k0_ * ldk2); \
    _Pragma("unroll") for (int q_ = 0; q_ < NKP; ++q_) ATT_BLD(ks[q_], ksrd, kgo0, sk_, 128 * q_); } while (0)
#define ATT_VWRITE_ASM(b) do { const int va_ = vla + (b) * SHM_V; ATT_DSW(va_, 0, vs0); ATT_DSW(va_, 8192, vs1); } while (0)
#define ATT_KWRITE_ASM(b) do { const int ka_ = kla + (b) * SHM_K; _Pragma("unroll") for (int q_ = 0; q_ < NKP; ++q_) ATT_DSW(ka_, 128 * q_, ks[q_]); } while (0)
#pragma unroll
  for (int q_ = 0; q_ < NKP; ++q_) ks[q_] = ld16(krs, kgo0 + 128 * q_, 0);
  asm volatile("s_waitcnt vmcnt(0)" ::: "memory");
#pragma unroll
  for (int q_ = 0; q_ < NKP; ++q_) *(bf16x8*)(K_lds + klo0 + 128 * q_) = ks[q_];
  __syncthreads();
#pragma unroll
  for (int d0 = 0; d0 < C_::NQR; ++d0) asm volatile("" :: "v"(qr[d0]));
  const int grp = __builtin_amdgcn_readfirstlane(wid >> 2);
  f32x16 p0 = {}, p1 = {}; bf16x8 pa0 = {}, pa1 = {}, pa2 = {}, pa3 = {}; float alpha_c = 1.f; int sflag = 0;
  vs0 = bf16x8{}; vs1 = bf16x8{};
#define ATT_EVEN_HEAD(te, issuer) do { sflag = 0; if ((te) < NT) { ATT_VLOAD_ASM(te); if ((te) + 1 < NT) ATT_KLOAD_ASM((te) + 1); if (sd.step_load(tid, issuer) && (issuer)) sflag = 1; } } while (0)
#define ATT_WAIT_ASM(NY, ...) asm volatile("s_cmp_eq_u32 %[flag], 0\n\ts_cbranch_scc1 .Latt_w0_%=\n\ts_waitcnt vmcnt(" #NY ")\n\ts_branch .Latt_w1_%=\n.Latt_w0_%=:\n\ts_waitcnt vmcnt(0)\n.Latt_w1_%=:" : __VA_ARGS__ : [flag] "s"(s2_) : "memory", "scc")
#define ATT_ODD_TAIL(te, NY) do { if ((te) < NT) { const int s2_ = __builtin_amdgcn_readfirstlane(sflag); \
      if constexpr (NKP == 2) ATT_WAIT_ASM(NY, "+v"(vs0), "+v"(vs1), "+v"(ks[0]), "+v"(ks[1])); else ATT_WAIT_ASM(NY, "+v"(vs0), "+v"(vs1), "+v"(ks[0]), "+v"(ks[1]), "+v"(ks[NKP - 1])); \
      ATT_VWRITE_ASM((te) & 1); if ((te) + 1 < NT) ATT_KWRITE_ASM(((te) + 1) & 1); } } while (0)
#define ATT_HBAR() do { ATT_SBAR(); asm volatile("s_waitcnt lgkmcnt(0)" ::: "memory"); __builtin_amdgcn_s_barrier(); asm volatile("" ::: "memory"); ATT_SBAR(); } while (0)
#define ATT_MSEG(t) do { __builtin_amdgcn_s_setprio(1); bf16x8 kfa_ = {}, kfb_ = {}; const int ksb_ = (int)(uintptr_t)K_lds + ((t) & 1) * SHM_K; if ((t) < NT) qkt_pre<DK>(kfa_, kfb_, ksb_, kx); \
      if ((t) >= 1) { if (__any(alpha_c < 1.f)) { if (hi == 0) al_l[r32] = alpha_c; asm volatile("s_waitcnt lgkmcnt(0)" ::: "memory"); \
          _Pragma("unroll") for (int d = 0; d < 4; ++d) _Pragma("unroll") for (int r = 0; r < 16; ++r) o[d][r] *= al_l[crow(r, hi)]; } \
        ATT_SBAR(); pv_d0(o, vb0 + (((t) - 1) & 1) * SHM_V, pa0, pa1, pa2, pa3); } \
      if ((t) < NT) qkt<DK, NA>(p0, p1, kfa_, kfb_, ksb_, qr, qlds, kx, hi, nw, (t)); \
      __builtin_amdgcn_s_setprio(0); } while (0)
#define ATT_SSEG() do { float mn_, alpha_; partialSM<DK>(p0, p1, m_reg, mn_, alpha_); finishSM(p0, p1, alpha_, l_reg, pa0, pa1, pa2, pa3); alpha_c = alpha_; } while (0)
  if (grp == 0) {
    for (int te = 0; te <= NT; ++te) {
      ATT_EVEN_HEAD(te, false); ATT_MSEG(te); ATT_HBAR();
      if (te < NT) ATT_SSEG();
      if (sd.step_emit(tid, true)) sflag = 1;
      ATT_ODD_TAIL(te, 2); ATT_HBAR();
    }
  } else {
    for (int te = 0; te <= NT; ++te) {
      ATT_EVEN_HEAD(te, true); if (te >= 1) ATT_SSEG();
      ATT_HBAR();
      ATT_MSEG(te); sd.step_emit(tid, false); ATT_ODD_TAIL(te, 4); ATT_HBAR();
    }
  }
#undef ATT_EVEN_HEAD
#undef ATT_WAIT_ASM
#undef ATT_ODD_TAIL
#undef ATT_HBAR
#undef ATT_MSEG
#undef ATT_SSEG
#undef ATT_VLOAD_ASM
#undef ATT_KLOAD_ASM
#undef ATT_VWRITE_ASM
#undef ATT_KWRITE_ASM
  if (hi == 0) li_l[r32] = l_reg; asm volatile("s_waitcnt lgkmcnt(0)" ::: "memory");
  float rli[16];
#pragma unroll
  for (int r = 0; r < 16; ++r) rli[r] = __builtin_amdgcn_rcpf(li_l[crow(r, hi)]);
  bf16* Ow = Ob + (long)(wid * QBLK) * ldo;
#pragma unroll
  for (int r = 0; r < 16; ++r) { const int orow = crow(r, hi);
#pragma unroll
    for (int d0 = 0; d0 < 4; ++d0) Ow[(long)orow * ldo + d0 * 32 + r32] = (bf16)(cvtpk(o[d0][r] * rli[r], 0.f) & 0xffffu); }
#undef ATT_KOFF
#undef ATT_VOFF
#undef ATT_SLOAD
#undef ATT_SWRITE
#undef ATT_SWRITE_ASM
#undef ATT_SLOAD_ASM
#undef ATT_BLD
#undef ATT_DSW
}

}
#define GAS __attribute__((address_space(1)))
#define LAS __attribute__((address_space(3)))
typedef unsigned short bf16;
typedef unsigned v4u __attribute__((ext_vector_type(4)));
typedef unsigned v2u __attribute__((ext_vector_type(2)));
typedef float f32x4 __attribute__((ext_vector_type(4)));
typedef short bf16x8 __attribute__((ext_vector_type(8)));
constexpr int NWAVES = 8;
constexpr int DM = 4096, SEQ = 4096, CTXL = 256, DFF = 10240, NLAT = 8192, NCTXR = 512, MROWS = 8704, NKEY = 4352, NMOD = 9;
constexpr int EVN = 9216, DLN = 1792, UQN = 6144, UKVN = 8192;
constexpr float EPS = 1e-6f;
constexpr size_t MiB = 1u << 20;
constexpr size_t WS_CTL = 0, CTL_ZERO_BYTES = 1 * MiB;
constexpr size_t WS_MOD = 1 * MiB;
constexpr size_t WS_WT1 = 2 * MiB, WT1_SZ = 160 * MiB;
constexpr size_t WS_WT2 = 642 * MiB, WT2_SZ = 80 * MiB;
constexpr size_t WS_WIN = 962 * MiB, WS_WOUT = 1034 * MiB, WS_WDOWN = 1066 * MiB, WS_WUQ = 1080 * MiB, WS_WUKV = 1092 * MiB, WS_WO = 1100 * MiB;
constexpr size_t WS_HA = 1132 * MiB, WS_HB = 1268 * MiB;
constexpr size_t WS_U = 1404 * MiB;
constexpr size_t WS_HID = 1472 * MiB;
constexpr size_t WS_AO = 1642 * MiB;
constexpr size_t WS_P = 1710 * MiB;
constexpr size_t WS_QB = 1863 * MiB;
constexpr size_t WS_KN = 1931 * MiB, WS_VN = 1965 * MiB;
constexpr size_t WS_KG = 1999 * MiB, WS_VG = 2008 * MiB;
constexpr size_t WS_DL = 2017 * MiB;
constexpr size_t WS_CQN = 2077 * MiB, WS_CKVN = 2094 * MiB, WS_KR = 2103 * MiB;
constexpr size_t WS_QRAW = 2105 * MiB, WS_KVRAW = 2201 * MiB;
constexpr size_t WS_QM = 2337 * MiB, WS_KM = 2433 * MiB, WS_VM = 2535 * MiB;
constexpr size_t WS_SLAB = 2603 * MiB;
constexpr size_t WS_DBG = 2667 * MiB;
constexpr size_t WS_END = 2668 * MiB;
constexpr int CW_BAR = 4096;
constexpr int RING_BYTES = 131072, LDS_BYTES = 147456, LDSCTL_OFF = LDS_BYTES - 1024, MISC_OFF = LDSCTL_OFF + 320;

#define LDS_WAIT() asm volatile("s_waitcnt lgkmcnt(0)" ::: "memory")
#define VM_WAIT() asm volatile("s_waitcnt vmcnt(0)" ::: "memory")
__device__ __forceinline__ unsigned f2bf(float f) { unsigned u = __builtin_bit_cast(unsigned, f); return (u + 0x7fffu + ((u >> 16) & 1u)) >> 16; }
__device__ __forceinline__ unsigned pk2(float lo, float hi) { return f2bf(lo) | (f2bf(hi) << 16); }
__device__ __forceinline__ float bf2f(unsigned short b) { return __builtin_bit_cast(float, ((unsigned)b) << 16); }
__device__ __forceinline__ float bflo(unsigned w) { return __builtin_bit_cast(float, w << 16); }
__device__ __forceinline__ float bfhi(unsigned w) { return __builtin_bit_cast(float, w & 0xffff0000u); }

#define XB_TMO      128
#define XB_XCNT(j)  (256  + 64 * (j))
#define XB_XSUB(j)  (1280 + 64 * (j))
#define XB_XGEN(j)  (2304 + 64 * (j))
#define XB_TOP      3328
#define XB_TOPGEN   3392
#define XCD_BAR_WORDS 3456
#define XB_SPIN_CAP (1u << 22)
__device__ __forceinline__ unsigned xb_ld(unsigned* p)              { return __hip_atomic_load(p, __ATOMIC_RELAXED, __HIP_MEMORY_SCOPE_AGENT); }
__device__ __forceinline__ unsigned xb_add(unsigned* p, unsigned v) { return __hip_atomic_fetch_add(p, v, __ATOMIC_RELAXED, __HIP_MEMORY_SCOPE_AGENT); }
__device__ __forceinline__ unsigned xb_xcc_id() { return (unsigned)__builtin_amdgcn_s_getreg((3 << 11) | 20) & 0xFu; }
#define XB_SPIN(cond, bar) do { unsigned _sp = 0; while (cond) { __builtin_amdgcn_s_sleep(1); \
    if ((++_sp & 255u) == 0u) { if (xb_ld(&(bar)[XB_TMO])) break; if (_sp > XB_SPIN_CAP) { atomicAdd(&(bar)[XB_TMO], 1u); break; } } } } while (0)
struct XcdBarrier { unsigned* bar; unsigned x; volatile LAS unsigned* st; };
__device__ __forceinline__ XcdBarrier xcd_barrier_post(unsigned* bar, volatile LAS unsigned* st) {
    XcdBarrier b; b.bar = bar; b.x = xb_xcc_id(); b.st = st;
    if (threadIdx.x == 0) (void)xb_add(&bar[XB_XCNT(b.x)], 1u);
    return b;
}
__device__ __forceinline__ void xcd_barrier_complete(unsigned* bar, unsigned x, unsigned& nloc, unsigned& nx) {
    const unsigned G = gridDim.x * gridDim.y * gridDim.z;
    unsigned sum, cnt, mine, sp = 0u;
    for (;;) {
        sum = 0u; cnt = 0u; mine = 0u;
#pragma unroll
        for (unsigned j = 0; j < 16; ++j) { const unsigned c = xb_ld(&bar[XB_XCNT(j)]); sum += c; cnt += (c > 0u) ? 1u : 0u; mine = (j == x) ? c : mine; }
        if (sum == G) break;
        __builtin_amdgcn_s_sleep(1);
        if ((++sp & 255u) == 0u) { if (xb_ld(&bar[XB_TMO])) break; if (sp > XB_SPIN_CAP) { atomicAdd(&bar[XB_TMO], 1u); break; } }
    }
    nloc = mine > 0u ? mine : 1u; nx = cnt > 0u ? cnt : 1u;
}
__device__ __forceinline__ void xcd_barrier(const XcdBarrier& b) {
    asm volatile("s_waitcnt vmcnt(0)" ::: "memory");
    __syncthreads();
    if (threadIdx.x == 0) {
        unsigned* bar = b.bar;
        __builtin_amdgcn_s_waitcnt(0);
        unsigned nloc = b.st[0], nx = b.st[1];
        if (nloc == 0u) { xcd_barrier_complete(bar, b.x, nloc, nx); b.st[0] = nloc; b.st[1] = nx; }
        const unsigned old = xb_add(&bar[XB_XSUB(b.x)], 1u);
        const unsigned gen = old / nloc;
        if (old + 1u == (gen + 1u) * nloc) {
            __builtin_amdgcn_fence(__ATOMIC_RELEASE, "agent");
            asm volatile("s_waitcnt vmcnt(0)" ::: "memory");
            const unsigned og = xb_add(&bar[XB_TOP], 1u);
            const unsigned tg = og / nx;
            if (og + 1u == (tg + 1u) * nx) xb_add(&bar[XB_TOPGEN], 1u);
            else XB_SPIN(xb_ld(&bar[XB_TOPGEN]) == tg, bar);
            __builtin_amdgcn_fence(__ATOMIC_ACQUIRE, "agent");
            xb_add(&bar[XB_XGEN(b.x)], 1u);
            asm volatile("s_waitcnt vmcnt(0)" ::: "memory");
        } else {
            XB_SPIN(xb_ld(&bar[XB_XGEN(b.x)]) == gen, bar);
            __builtin_amdgcn_fence(__ATOMIC_ACQUIRE, "agent");
            asm volatile("s_waitcnt vmcnt(0)" ::: "memory");
        }
    }
    __syncthreads();
}

struct Args { const float* in[26]; float* out; unsigned char* ws; int ph_lo, ph_hi, chk, pad; };
struct Ctx {
    LAS unsigned char* lds; int tid, lane, wave, vcu, G;
    const float* const* in; float* out; unsigned char* ws;
};
__device__ __forceinline__ float wave_sum(float v) {
#pragma unroll
    for (int o = 1; o < 64; o <<= 1) v += __shfl_xor(v, o);
    return v;
}
#ifndef CV_NT
#define CV_NT 1
#endif
__device__ __forceinline__ void p0_transpose_item(const float* W, int K, int N, bf16* WT, int drow0, LAS float* scr, int k0, int n0, int lane) {
    const int c4 = (lane & 15) * 4, kq = lane >> 4;
    f32x4 v[16];
#pragma unroll
    for (int i = 0; i < 16; ++i) v[i] = CV_NT ? __builtin_nontemporal_load((const f32x4*)(W + (size_t)(k0 + 4 * i + kq) * N + n0 + c4)) : *(const f32x4*)(W + (size_t)(k0 + 4 * i + kq) * N + n0 + c4);
#pragma unroll
    for (int i = 0; i < 16; ++i) { LAS float* d = scr + (4 * i + kq) * 65 + c4; d[0] = v[i].x; d[1] = v[i].y; d[2] = v[i].z; d[3] = v[i].w; }
    LDS_WAIT(); asm volatile("" ::: "memory");
    const int c = lane & 7;
#pragma unroll
    for (int j = 0; j < 8; ++j) { const int n = (lane >> 3) + 8 * j; const LAS float* s = scr + (8 * c) * 65 + n;
        v4u o; o.x = pk2(s[0 * 65], s[1 * 65]); o.y = pk2(s[2 * 65], s[3 * 65]); o.z = pk2(s[4 * 65], s[5 * 65]); o.w = pk2(s[6 * 65], s[7 * 65]);
        const int dr = drow0 + n;
        GAS v4u* dp = (GAS v4u*)(WT + (((size_t)(dr >> 8) * (K >> 6) + (k0 >> 6)) * 256 + (dr & 255)) * 64 + 8 * c);
        if (CV_NT) __builtin_nontemporal_store(o, dp); else *dp = o; }
    LDS_WAIT(); asm volatile("" ::: "memory");
}
constexpr int CV_W1_ITEMS = (DM / 64) * (2 * DFF / 64), CV_W2_ITEMS = (DFF / 64) * (DM / 64), CV_WIN_ITEMS = (DM / 64) * (EVN / 64), CV_SQ_ITEMS = (DM / 64) * (DM / 64),
              CV_DOWN_ITEMS = (DM / 64) * (1600 / 64), CV_UQ_ITEMS = (1024 / 64) * (UQN / 64), CV_UKV_ITEMS = (512 / 64) * (UKVN / 64);
constexpr int CV_E0 = CV_W1_ITEMS, CV_E1 = CV_E0 + CV_W2_ITEMS, CV_E2 = CV_E1 + CV_WIN_ITEMS, CV_E3 = CV_E2 + CV_SQ_ITEMS, CV_E4 = CV_E3 + CV_W1_ITEMS, CV_E5 = CV_E4 + CV_W2_ITEMS,
              CV_E6 = CV_E5 + CV_W1_ITEMS, CV_E7 = CV_E6 + CV_W2_ITEMS, CV_E8 = CV_E7 + CV_DOWN_ITEMS, CV_E9 = CV_E8 + CV_UQ_ITEMS, CV_E10 = CV_E9 + CV_UKV_ITEMS, CV_E11 = CV_E10 + CV_SQ_ITEMS,
              CV_E12 = CV_E11 + CV_W1_ITEMS, CV_TOTAL = CV_E12 + CV_W2_ITEMS;
#ifndef CV_T2
#define CV_T2 18000
#define CV_T5 10000
#define CV_A7 27296
#define CV_T10 18000
#define CV_T13 18000
#define CV_T16 3000
#define CV_T18 4000
#define CV_A20 24216
#endif
constexpr int CV_P0 = CV_TOTAL - (CV_T2 + CV_T5 + CV_A7 + CV_T10 + CV_T13 + CV_T16 + CV_T18 + CV_A20);
constexpr int CV_S2 = CV_P0, CV_S5 = CV_S2 + CV_T2, CV_S7 = CV_S5 + CV_T5, CV_S10 = CV_S7 + CV_A7, CV_S13 = CV_S10 + CV_T10, CV_S16 = CV_S13 + CV_T13, CV_S18 = CV_S16 + CV_T16, CV_S20 = CV_S18 + CV_T18;
static_assert(CV_S20 + CV_A20 == CV_TOTAL && CV_P0 >= CV_E0, "conversion schedule: P0 must at least cover the first SwiGLU weight");
static_assert(CV_S5 >= CV_E2, "W2[l0,f0] and W_in are converted by the end of phase 2's tail");
static_assert(CV_S10 >= CV_E4, "W_out and W1[l0,f1] are converted by the end of phase 7");
static_assert(CV_S13 >= CV_E6, "W2[l0,f1] and W1[l1,f0] are converted by the end of phase 10's tail");
static_assert(CV_S16 >= CV_E8, "W2[l1,f0] and W_down are converted by the end of phase 13's tail");
static_assert(CV_S18 >= CV_E10, "W_uq and W_ukv are converted by the end of phase 16's tail");
static_assert(CV_A7 <= 156 * 256 && CV_A20 <= 268 * 256, "attention side stream: every workgroup has at least 156 (phase 7) / 268 (phase 20) tile slots");
__device__ __forceinline__ void cv_decode(const Args& a, int it, const float*& W, bf16*& WT, int& K, int& N, int& swi, int& kb, int& nb) {
    unsigned char* ws = a.ws; int r; swi = 0;
#define CV_CASE(lim, base, Wp, WTp, Kv, Nv, sw) if (it < (lim)) { r = it - (base); W = (Wp); WT = (bf16*)(WTp); K = (Kv); N = (Nv); swi = (sw); kb = r / ((Nv) / 64); nb = r - kb * ((Nv) / 64); }
    CV_CASE(CV_E0, 0, a.in[7], ws + WS_WT1, DM, 2 * DFF, 1)
    else CV_CASE(CV_E1, CV_E0, a.in[8], ws + WS_WT2, DFF, DM, 0)
    else CV_CASE(CV_E2, CV_E1, a.in[9], ws + WS_WIN, DM, EVN, 0)
    else CV_CASE(CV_E3, CV_E2, a.in[10], ws + WS_WOUT, DM, DM, 0)
    else CV_CASE(CV_E4, CV_E3, a.in[7] + (size_t)1 * DM * 2 * DFF, ws + WS_WT1 + (size_t)1 * WT1_SZ, DM, 2 * DFF, 1)
    else CV_CASE(CV_E5, CV_E4, a.in[8] + (size_t)1 * DFF * DM, ws + WS_WT2 + (size_t)1 * WT2_SZ, DFF, DM, 0)
    else CV_CASE(CV_E6, CV_E5, a.in[7] + (size_t)2 * DM * 2 * DFF, ws + WS_WT1 + (size_t)2 * WT1_SZ, DM, 2 * DFF, 1)
    else CV_CASE(CV_E7, CV_E6, a.in[8] + (size_t)2 * DFF * DM, ws + WS_WT2 + (size_t)2 * WT2_SZ, DFF, DM, 0)
    else CV_CASE(CV_E8, CV_E7, a.in[16], ws + WS_WDOWN, DM, 1600, 0)
    else CV_CASE(CV_E9, CV_E8, a.in[19], ws + WS_WUQ, 1024, UQN, 0)
    else CV_CASE(CV_E10, CV_E9, a.in[20], ws + WS_WUKV, 512, UKVN, 0)
    else CV_CASE(CV_E11, CV_E10, a.in[25], ws + WS_WO, DM, DM, 0)
    else CV_CASE(CV_E12, CV_E11, a.in[7] + (size_t)3 * DM * 2 * DFF, ws + WS_WT1 + (size_t)3 * WT1_SZ, DM, 2 * DFF, 1)
    else { r = it - CV_E12; W = a.in[8] + (size_t)3 * DFF * DM; WT = (bf16*)(ws + WS_WT2 + (size_t)3 * WT2_SZ); K = DFF; N = DM; kb = r / (DM / 64); nb = r - kb * (DM / 64); }
#undef CV_CASE
}
__device__ __forceinline__ void p0_convert(const Args& a, LAS unsigned char* lds, int first, int last, int widx, int nw, int wave, int lane) {
    LAS float* scr = (LAS float*)(lds + wave * 16640);
    for (int it = first + widx; it < last; it += nw) {
        const float* W; bf16* WT; int K, N, swi, kb, nb; cv_decode(a, it, W, WT, K, N, swi, kb, nb);
        const int n0 = 64 * nb;
        int drow0 = n0;
        if (swi) { drow0 = n0 < DFF ? (n0 >> 7) * 256 + (n0 & 127) : ((n0 - DFF) >> 7) * 256 + 128 + ((n0 - DFF) & 127); }
        p0_transpose_item(W, K, N, WT, drow0, scr, 64 * kb, n0, lane);
    }
}
__device__ __forceinline__ void tail_convert(const Args& a, LAS unsigned char* lds, int nwg, int G, int c, int first, int count, int wave, int lane) {
    const int rem = nwg % G, nfree = rem == 0 ? G : G - rem, f = rem == 0 ? c : c - rem;
    if (f < 0) return;
    __syncthreads();
    p0_convert(a, lds, first, first + count, f * NWAVES + wave, nfree * NWAVES, wave, lane);
}
__device__ __forceinline__ float silu_f(float x) { return x / (1.0f + __expf(-x)); }
__device__ __forceinline__ void p0_mod(const Args& a, LAS unsigned char* lds, int c, int G, int tid) {
    LAS float* sl = (LAS float*)lds;
    LAS float* red = (LAS float*)(lds + 49152);
    for (int i = tid; i < 3 * DM; i += 512) { const int v = i >> 12, k = i & 4095; const float x = v < 2 ? a.in[1][v * DM + k] : a.in[3][k]; sl[i] = silu_f(x); }
    __syncthreads();
    const int cl = tid & 7, ks = tid >> 3;
    float* mod = (float*)(a.ws + WS_MOD);
    constexpr int NCG = NMOD * DM / 32;
    for (int u = c; u < 2 * NCG; u += G) {
        const int l = u / NCG, cg = u - l * NCG;
        const float* wp = a.in[5] + ((size_t)l * DM + ks * 64) * (NMOD * DM) + cg * 32 + cl * 4;
        f32x4 a0 = {0.f, 0.f, 0.f, 0.f}, a1 = a0, a2 = a0;
#pragma unroll 16
        for (int k = 0; k < 64; ++k) { const f32x4 w = __builtin_nontemporal_load((const f32x4*)(wp + (size_t)k * (NMOD * DM))); const int kk = ks * 64 + k;
            a0 += w * sl[kk]; a1 += w * sl[DM + kk]; a2 += w * sl[2 * DM + kk]; }
        LAS float* rp = red + (ks * 8 + cl) * 12;
        *(LAS f32x4*)(rp) = a0; *(LAS f32x4*)(rp + 4) = a1; *(LAS f32x4*)(rp + 8) = a2;
        __syncthreads();
        if (tid < 96) { const int cl2 = tid & 7, comp = tid >> 3; float s = 0.f;
#pragma unroll 8
            for (int q2 = 0; q2 < 64; ++q2) s += red[(q2 * 8 + cl2) * 12 + comp];
            const int v = comp >> 2, e2 = comp & 3, col = cg * 32 + cl2 * 4 + e2;
            mod[((size_t)l * 3 + v) * (NMOD * DM) + col] = s + a.in[6][l * (NMOD * DM) + col]; }
        __syncthreads();
    }
}
__device__ __forceinline__ void p0_zero_pad(const Args& a, int c, int G, int tid) {
    const v4u z = {0u, 0u, 0u, 0u}; constexpr int PER = 192 * 64 * 2 / 16;
    for (int i = c * 512 + tid; i < 64 * PER; i += G * 512) { const int kb = i / PER, r = i - kb * PER;
        v4u* p = (v4u*)(a.ws + WS_WDOWN + ((((size_t)6 * 64 + kb) * 256 + 64) * 64) * 2); p[r] = z; }
}

__device__ __forceinline__ void modulate_phase(const float* src_lat, const float* src_ctx, const float* g, const float* modl  , int ishift, int iscale,
                                               bf16* U, int M, int gw, int NGW, int lane, const float* slab, const float* sgate, float gs, float* hout_ctx, LAS unsigned char* lds) {
    const int M_wave = slab != nullptr ? NLAT : M;
    LAS float* gl = (LAS float*)(lds + 1024);
    { const int tid_ = (gw & 7) * 64 + lane;
      for (int i = tid_; i < 3 * (DM / 4); i += NWAVES * 64) { const int vec_ = i / (DM / 4), c4 = (i - vec_ * (DM / 4)) * 4;
          const f32x4 g4 = *(const f32x4*)(g + c4), sc4 = *(const f32x4*)(modl + ((size_t)vec_ * NMOD + iscale) * DM + c4), sh4 = *(const f32x4*)(modl + ((size_t)vec_ * NMOD + ishift) * DM + c4);
          *(LAS f32x4*)(gl + (vec_ * 2 + 0) * DM + c4) = g4 * (sc4 + 1.0f); *(LAS f32x4*)(gl + (vec_ * 2 + 1) * DM + c4) = sh4; }
      __syncthreads(); }
    if (slab != nullptr) {
        const int wv = gw & 7, blk = gw >> 3, nblk = NGW >> 3; LAS float* red = (LAS float*)lds;
        int par = 0;
        for (int r = blk; r < NCTXR; r += nblk) {
            const float* srow = src_ctx + (size_t)r * DM; const float* sp = slab + (size_t)r * DM; float* ho = hout_ctx + (size_t)r * DM;
            f32x4 hv[2], tt[2][8], gt[2];
#pragma unroll
            for (int q2 = 0; q2 < 2; ++q2) { const int ci = 4 * (lane + 64 * (2 * wv + q2)); hv[q2] = *(const f32x4*)(srow + ci); gt[q2] = *(const f32x4*)(sgate + ci);
#pragma unroll
                for (int s = 0; s < 8; ++s) tt[q2][s] = *(const f32x4*)(sp + (size_t)s * 512 * DM + ci); }
            float ss = 0.f;
#pragma unroll
            for (int q2 = 0; q2 < 2; ++q2) { const f32x4 sum = ((tt[q2][0] + tt[q2][1]) + (tt[q2][2] + tt[q2][3])) + ((tt[q2][4] + tt[q2][5]) + (tt[q2][6] + tt[q2][7]));
                hv[q2] += (gt[q2] * gs) * sum; ss += (hv[q2].x * hv[q2].x + hv[q2].y * hv[q2].y) + (hv[q2].z * hv[q2].z + hv[q2].w * hv[q2].w); }
#pragma unroll
            for (int q2 = 0; q2 < 2; ++q2) { const int ci = 4 * (lane + 64 * (2 * wv + q2)); *(f32x4*)(ho + ci) = hv[q2]; }
            ss = wave_sum(ss);
            if (lane == 0) red[par * 8 + wv] = ss;
            __syncthreads();
            float tot = 0.f;
#pragma unroll
            for (int w2 = 0; w2 < 8; ++w2) tot += red[par * 8 + w2];
            par ^= 1;
            const float rstd = 1.0f / sqrtf(tot * (1.0f / DM) + EPS);
            v2u* o8 = (v2u*)(U + (size_t)(NLAT + r) * DM);
#pragma unroll
            for (int q2 = 0; q2 < 2; ++q2) { const int ci = 4 * (lane + 64 * (2 * wv + q2));
                const f32x4 y = (hv[q2] * rstd) * *(const LAS f32x4*)(gl + 4 * DM + ci) + *(const LAS f32x4*)(gl + 5 * DM + ci);
                v2u w; w.x = pk2(y.x, y.y); w.y = pk2(y.z, y.w); o8[lane + 64 * (2 * wv + q2)] = w; }
        }
    }
    f32x4 vn[16];
    if (gw < M_wave) { const float* src0 = gw < NLAT ? src_lat + (size_t)gw * DM : src_ctx + (size_t)(gw - NLAT) * DM;
#pragma unroll
        for (int j = 0; j < 16; ++j) vn[j] = *(const f32x4*)(src0 + 4 * (lane + 64 * j)); }
    for (int row = gw; row < M_wave; row += NGW) {
        const int vec = row < SEQ ? 0 : (row < NLAT ? 1 : 2);
        f32x4 v[16]; float ss = 0.f;
#pragma unroll
        for (int j = 0; j < 16; ++j) v[j] = vn[j];
        { const int nrow = row + NGW;
          if (nrow < M_wave) { const float* srcn = nrow < NLAT ? src_lat + (size_t)nrow * DM : src_ctx + (size_t)(nrow - NLAT) * DM;
#pragma unroll
            for (int j = 0; j < 16; ++j) vn[j] = *(const f32x4*)(srcn + 4 * (lane + 64 * j)); } }
        __builtin_amdgcn_sched_barrier(0);
#pragma unroll
        for (int j = 0; j < 16; ++j) ss += (v[j].x * v[j].x + v[j].y * v[j].y) + (v[j].z * v[j].z + v[j].w * v[j].w);
        const float rstd = 1.0f / sqrtf(wave_sum(ss) * (1.0f / DM) + EPS);
        v2u* o8 = (v2u*)(U + (size_t)row * DM);
#pragma unroll
        for (int j = 0; j < 16; ++j) { const int ci = 4 * (lane + 64 * j);
            const f32x4 y = (v[j] * rstd) * *(const LAS f32x4*)(gl + (vec * 2 + 0) * DM + ci) + *(const LAS f32x4*)(gl + (vec * 2 + 1) * DM + ci);
            v2u w; w.x = pk2(y.x, y.y); w.y = pk2(y.z, y.w); o8[lane + 64 * j] = w; }
        __builtin_amdgcn_sched_barrier(0);
    }
}

__device__ __forceinline__ void rope_cs(float pos, int f, float l2step  , float& c, float& s) {
    const float ang = pos * __builtin_amdgcn_exp2f(-(float)f * l2step);
    const float rev = ang * 0.15915494309189535f;
    s = __builtin_amdgcn_sinf(rev); c = __builtin_amdgcn_cosf(rev);
}
__device__ __forceinline__ void unpack8(const v4u w, float (&x)[8]) { x[0] = bflo(w.x); x[1] = bfhi(w.x); x[2] = bflo(w.y); x[3] = bfhi(w.y); x[4] = bflo(w.z); x[5] = bfhi(w.z); x[6] = bflo(w.w); x[7] = bfhi(w.w); }
__device__ __forceinline__ v4u pack8(const float (&x)[8]) { v4u w; w.x = pk2(x[0], x[1]); w.y = pk2(x[2], x[3]); w.z = pk2(x[4], x[5]); w.w = pk2(x[6], x[7]); return w; }
__device__ __forceinline__ float sum16(float v) { v += __shfl_xor(v, 1); v += __shfl_xor(v, 2); v += __shfl_xor(v, 4); v += __shfl_xor(v, 8); return v; }

template <int KIND  >
__device__ __forceinline__ void prep_even_group(const v4u w, int lane, bool latent, float prow_f, float pcol_f, const f32x4 g0, const f32x4 g1, bf16* dst  , int dst_slot_stride) {
    const int i = lane & 15, sl = lane >> 4;
    bf16* d = dst + (size_t)sl * dst_slot_stride + i * 8;
    if constexpr (KIND == 3 || KIND == 5) { *(v4u*)d = w; return; }
    float x[8]; unpack8(w, x);
    float ss = 0.f;
#pragma unroll
    for (int e = 0; e < 8; ++e) ss += x[e] * x[e];
    const float rstd = 1.0f / sqrtf(sum16(ss) * (1.0f / 128.0f) + EPS);
    x[0] *= rstd * g0.x; x[1] *= rstd * g0.y; x[2] *= rstd * g0.z; x[3] *= rstd * g0.w; x[4] *= rstd * g1.x; x[5] *= rstd * g1.y; x[6] *= rstd * g1.z; x[7] *= rstd * g1.w;
    if constexpr (KIND == 1 || KIND == 4) {
        const int i8 = i & 7; const float pos = i8 < 4 ? prow_f : pcol_f; const int f0 = (i8 & 3) * 8;
#pragma unroll
        for (int e = 0; e < 8; ++e) { const float other = __shfl_xor(x[e], 8); float c, s; rope_cs(pos, f0 + e, 0.41524101186092029f, c, s);
            const float r = i < 8 ? x[e] * c - other * s : other * s + x[e] * c; x[e] = latent ? r : x[e]; }
    }
    *(v4u*)d = pack8(x);
}
__device__ __forceinline__ void prep_even_phase(const Args& a, int gw, int NGW, int lane) {
    unsigned char* ws = a.ws; const bf16* P = (const bf16*)(ws + WS_P);
    bf16* QB = (bf16*)(ws + WS_QB); bf16* KN = (bf16*)(ws + WS_KN); bf16* KG = (bf16*)(ws + WS_KG);
    const int gi_ = (lane & 15) * 8; const f32x4 z4 = {0.f, 0.f, 0.f, 0.f};
    const f32x4 nq0 = *(const f32x4*)(a.in[11] + gi_), nq1 = *(const f32x4*)(a.in[11] + gi_ + 4), gq0 = *(const f32x4*)(a.in[14] + gi_), gq1 = *(const f32x4*)(a.in[14] + gi_ + 4);
    const f32x4 nk0 = *(const f32x4*)(a.in[12] + gi_), nk1 = *(const f32x4*)(a.in[12] + gi_ + 4), gk0 = *(const f32x4*)(a.in[15] + gi_), gk1 = *(const f32x4*)(a.in[15] + gi_ + 4);
    for (int row = gw; row < MROWS; row += NGW) {
        const bool latent = row < NLAT; const int b = latent ? row >> 12 : (row - NLAT) >> 8; const int kidx = latent ? CTXL + (row & 4095) : (row - NLAT) & 255; const int t = row & 4095;
        const float prow_f = (float)(t >> 6), pcol_f = (float)(t & 63);
        const bf16* prow = P + (size_t)row * EVN; const size_t krow = (size_t)b * NKEY + kidx;
        v4u w[18];
#pragma unroll
        for (int grp = 0; grp < 18; ++grp) if (grp < 12 || grp == 16) w[grp] = *(const v4u*)(prow + grp * 512 + lane * 8);
#pragma unroll
        for (int grp = 0; grp < 4; ++grp) prep_even_group<0>(w[grp], lane, latent, prow_f, pcol_f, nq0, nq1, QB + (size_t)row * DM + grp * 512, 128);
#pragma unroll
        for (int grp = 4; grp < 8; ++grp) prep_even_group<1>(w[grp], lane, latent, prow_f, pcol_f, gq0, gq1, QB + (size_t)row * DM + grp * 512, 128);
#pragma unroll
        for (int grp = 8; grp < 12; ++grp) prep_even_group<2>(w[grp], lane, latent, prow_f, pcol_f, nk0, nk1, KN + krow * 2048 + (grp - 8) * 512, 128);
        prep_even_group<4>(w[16], lane, latent, prow_f, pcol_f, gk0, gk1, KG + krow * 512, 128);
    }
}

__device__ __forceinline__ void prep_mla1_phase(const Args& a, int gw, int NGW, int lane) {
    unsigned char* ws = a.ws; const float* DL = (const float*)(ws + WS_DL);
    bf16* CQN = (bf16*)(ws + WS_CQN); bf16* CKVN = (bf16*)(ws + WS_CKVN); bf16* KR = (bf16*)(ws + WS_KR);
    for (int row = gw; row < MROWS; row += NGW) {
        const float* d = DL + (size_t)row * DLN; const bool latent = row < NLAT; const int t = row & 4095;
        f32x4 q[4], kv[2], gq[4], gk[2]; float ss = 0.f;
#pragma unroll
        for (int j = 0; j < 4; ++j) { q[j] = *(const f32x4*)(d + 4 * (lane + 64 * j)); gq[j] = *(const f32x4*)(a.in[17] + 4 * (lane + 64 * j)); }
#pragma unroll
        for (int j = 0; j < 2; ++j) { kv[j] = *(const f32x4*)(d + 1024 + 4 * (lane + 64 * j)); gk[j] = *(const f32x4*)(a.in[18] + 4 * (lane + 64 * j)); }
        float x = d[1536 + lane]; const float gx = a.in[24][lane];
#pragma unroll
        for (int j = 0; j < 4; ++j) ss += (q[j].x * q[j].x + q[j].y * q[j].y) + (q[j].z * q[j].z + q[j].w * q[j].w);
        float rstd = 1.0f / sqrtf(wave_sum(ss) * (1.0f / 1024.0f) + EPS);
#pragma unroll
        for (int j = 0; j < 4; ++j) { const int ci = 4 * (lane + 64 * j); const f32x4 y = q[j] * rstd * gq[j];
            v2u w; w.x = pk2(y.x, y.y); w.y = pk2(y.z, y.w); *(v2u*)(CQN + (size_t)row * 1024 + ci) = w; }
        ss = 0.f;
#pragma unroll
        for (int j = 0; j < 2; ++j) ss += (kv[j].x * kv[j].x + kv[j].y * kv[j].y) + (kv[j].z * kv[j].z + kv[j].w * kv[j].w);
        rstd = 1.0f / sqrtf(wave_sum(ss) * (1.0f / 512.0f) + EPS);
#pragma unroll
        for (int j = 0; j < 2; ++j) { const int ci = 4 * (lane + 64 * j); const f32x4 y = kv[j] * rstd * gk[j];
            v2u w; w.x = pk2(y.x, y.y); w.y = pk2(y.z, y.w); *(v2u*)(CKVN + (size_t)row * 512 + ci) = w; }
        rstd = 1.0f / sqrtf(wave_sum(x * x) * (1.0f / 64.0f) + EPS);
        x = x * rstd * gx;
        { const int aidx = lane & 31; const float pos = aidx < 16 ? (float)(t >> 6) : (float)(t & 63); float c, s; rope_cs(pos, aidx & 15, 0.83048202372184058f, c, s);
          const float other = __shfl_xor(x, 32); const float r = lane < 32 ? x * c - other * s : other * s + x * c; x = latent ? r : x; }
        KR[(size_t)row * 64 + lane] = (bf16)f2bf(x);
    }
}
__device__ __forceinline__ void prep_mla2_phase(const Args& a, int gw, int NGW, int lane) {
    unsigned char* ws = a.ws; const bf16* QRAW = (const bf16*)(ws + WS_QRAW); const bf16* KVRAW = (const bf16*)(ws + WS_KVRAW); const bf16* KR = (const bf16*)(ws + WS_KR);
    bf16* QM = (bf16*)(ws + WS_QM); bf16* KM = (bf16*)(ws + WS_KM);
    const int i = lane & 15, g4 = lane >> 4;
    {
        const f32x4 gn0 = *(const f32x4*)(a.in[21] + i * 8), gn1 = *(const f32x4*)(a.in[21] + i * 8 + 4);
        const int i8 = i & 7; const f32x4 gr0 = *(const f32x4*)(a.in[22] + i8 * 8), gr1 = *(const f32x4*)(a.in[22] + i8 * 8 + 4);
        const int i4 = i & 3; const int f0 = (i4 & 1) * 8;
        v4u nn[8], nr[8];
        if (gw < NLAT) { const bf16* src0 = QRAW + (size_t)gw * UQN;
#pragma unroll
            for (int it = 0; it < 8; ++it) { const int h = it * 4 + g4; nn[it] = *(const v4u*)(src0 + h * 192 + i * 8); nr[it] = *(const v4u*)(src0 + h * 192 + 128 + i8 * 8); } }
        for (int row = gw; row < NLAT; row += NGW) {
            const int t = row & 4095; bf16* dst = QM + (size_t)row * UQN;
            const float pos = i4 < 2 ? (float)(t >> 6) : (float)(t & 63);
            v4u wn[8], wr[8];
#pragma unroll
            for (int it = 0; it < 8; ++it) { wn[it] = nn[it]; wr[it] = nr[it]; }
            if (row + NGW < NLAT) { const bf16* srcn = QRAW + (size_t)(row + NGW) * UQN;
#pragma unroll
                for (int it = 0; it < 8; ++it) { const int h = it * 4 + g4; nn[it] = *(const v4u*)(srcn + h * 192 + i * 8); nr[it] = *(const v4u*)(srcn + h * 192 + 128 + i8 * 8); } }
            __builtin_amdgcn_sched_barrier(0);
#pragma unroll
            for (int it = 0; it < 8; ++it) { const int h = it * 4 + g4;
                float x[8]; unpack8(wn[it], x);
                float ss = 0.f;
#pragma unroll
                for (int e = 0; e < 8; ++e) ss += x[e] * x[e];
                float rstd = 1.0f / sqrtf(sum16(ss) * (1.0f / 128.0f) + EPS);
                x[0] *= rstd * gn0.x; x[1] *= rstd * gn0.y; x[2] *= rstd * gn0.z; x[3] *= rstd * gn0.w; x[4] *= rstd * gn1.x; x[5] *= rstd * gn1.y; x[6] *= rstd * gn1.z; x[7] *= rstd * gn1.w;
                *(v4u*)(dst + h * 192 + i * 8) = pack8(x);
                float y[8]; unpack8(wr[it], y);
                ss = 0.f;
#pragma unroll
                for (int e = 0; e < 8; ++e) ss += y[e] * y[e];
                ss = i < 8 ? ss : 0.f;
                rstd = 1.0f / sqrtf(sum16(ss) * (1.0f / 64.0f) + EPS);
                y[0] *= rstd * gr0.x; y[1] *= rstd * gr0.y; y[2] *= rstd * gr0.z; y[3] *= rstd * gr0.w; y[4] *= rstd * gr1.x; y[5] *= rstd * gr1.y; y[6] *= rstd * gr1.z; y[7] *= rstd * gr1.w;
#pragma unroll
                for (int e = 0; e < 8; ++e) { const float other = __shfl_xor(y[e], 4); float c, s; rope_cs(pos, f0 + e, 0.83048202372184058f, c, s);
                    y[e] = i8 < 4 ? y[e] * c - other * s : other * s + y[e] * c; }
                if (i < 8) *(v4u*)(dst + h * 192 + 128 + i * 8) = pack8(y);
            }
            __builtin_amdgcn_sched_barrier(0);
        }
    }
    {
        const f32x4 gn0 = *(const f32x4*)(a.in[23] + i * 8), gn1 = *(const f32x4*)(a.in[23] + i * 8 + 4);
        v4u nk[8], nkr;
        if (gw < MROWS) { const bf16* src0 = KVRAW + (size_t)gw * UKVN; nkr = *(const v4u*)(KR + (size_t)gw * 64 + (i & 7) * 8);
#pragma unroll
            for (int it = 0; it < 8; ++it) { const int h = it * 4 + g4; nk[it] = *(const v4u*)(src0 + h * 256 + i * 8); } }
        for (int row = gw; row < MROWS; row += NGW) {
            const bool latent = row < NLAT; const int b = latent ? row >> 12 : (row - NLAT) >> 8; const int kidx = latent ? CTXL + (row & 4095) : (row - NLAT) & 255;
            const size_t krow = (size_t)b * NKEY + kidx; bf16* kd = KM + krow * UQN;
            v4u wk[8]; const v4u krw = nkr;
#pragma unroll
            for (int it = 0; it < 8; ++it) wk[it] = nk[it];
            if (row + NGW < MROWS) { const bf16* srcn = KVRAW + (size_t)(row + NGW) * UKVN; nkr = *(const v4u*)(KR + (size_t)(row + NGW) * 64 + (i & 7) * 8);
#pragma unroll
                for (int it = 0; it < 8; ++it) { const int h = it * 4 + g4; nk[it] = *(const v4u*)(srcn + h * 256 + i * 8); } }
            __builtin_amdgcn_sched_barrier(0);
#pragma unroll
            for (int it = 0; it < 8; ++it) { const int h = it * 4 + g4;
                float x[8]; unpack8(wk[it], x);
                float ss = 0.f;
#pragma unroll
                for (int e = 0; e < 8; ++e) ss += x[e] * x[e];
                const float rstd = 1.0f / sqrtf(sum16(ss) * (1.0f / 128.0f) + EPS);
                x[0] *= rstd * gn0.x; x[1] *= rstd * gn0.y; x[2] *= rstd * gn0.z; x[3] *= rstd * gn0.w; x[4] *= rstd * gn1.x; x[5] *= rstd * gn1.y; x[6] *= rstd * gn1.z; x[7] *= rstd * gn1.w;
                *(v4u*)(kd + h * 192 + i * 8) = pack8(x);
                if (i < 8) *(v4u*)(kd + h * 192 + 128 + i * 8) = krw;
            }
            __builtin_amdgcn_sched_barrier(0);
        }
    }
}

constexpr int CVS_OFF = 90112;
constexpr int CVS_TAB = CVS_OFF + 3 * 16384, CVS_MAXN = (LDSCTL_OFF - CVS_TAB) / 24;
__device__ __forceinline__ unsigned cv_pk(float lo, float hi) { unsigned r; asm("v_cvt_pk_bf16_f32 %0, %1, %2" : "=v"(r) : "v"(lo), "v"(hi)); return r; }
struct CvSide {
    LAS unsigned char* scr; int idx, n, bi, i0, i1, i2;
    __device__ __forceinline__ void init(const Args& a, LAS unsigned char* lds, int first, int count, int c, int G, int tid) {
        scr = lds + CVS_OFF; n = c < count ? (count - c + G - 1) / G : 0; idx = 0; bi = 0; i0 = -1; i1 = -1; i2 = -1;
        LAS unsigned* tab = (LAS unsigned*)(lds + CVS_TAB);
        __syncthreads();
        for (int i = tid; i < n; i += NWAVES * 64) {
            const float* W; bf16* WT; int K, N, swi, kb, nb; cv_decode(a, first + c + i * G, W, WT, K, N, swi, kb, nb);
            const int n0 = 64 * nb; int drow0 = n0;
            if (swi) { drow0 = n0 < DFF ? (n0 >> 7) * 256 + (n0 & 127) : ((n0 - DFF) >> 7) * 256 + 128 + ((n0 - DFF) & 127); }
            const unsigned long long sp = (unsigned long long)(W + (size_t)(64 * kb) * N + n0), dp = (unsigned long long)(WT + (((size_t)(drow0 >> 8) * (K >> 6) + kb) * 256 + (drow0 & 255)) * 64);
            tab[i * 6 + 0] = (unsigned)sp; tab[i * 6 + 1] = (unsigned)(sp >> 32); tab[i * 6 + 2] = (unsigned)dp; tab[i * 6 + 3] = (unsigned)(dp >> 32); tab[i * 6 + 4] = (unsigned)N * 4u; tab[i * 6 + 5] = 0u;
        }
        __syncthreads();
    }
    __device__ __forceinline__ bf16* dst_of(int ti) const {
        const LAS unsigned* e = (const LAS unsigned*)(scr + (CVS_TAB - CVS_OFF)) + ti * 6;
        const unsigned t0 = __builtin_amdgcn_readfirstlane(e[2]), t1 = __builtin_amdgcn_readfirstlane(e[3]);
        return (bf16*)(((unsigned long long)t1 << 32) | t0);
    }
    __device__ __forceinline__ void emit(bf16* dst, int buf, int t) {
        const int nn = t >> 3, cc = t & 7; const LAS float* s = (const LAS float*)(scr + buf * 16384 + (nn >> 2) * 128 + cc * 16 + (nn & 3) * 4);
        v4u o; o.x = cv_pk(s[0 * 512], s[1 * 512]); o.y = cv_pk(s[2 * 512], s[3 * 512]); o.z = cv_pk(s[4 * 512], s[5 * 512]); o.w = cv_pk(s[6 * 512], s[7 * 512]);
        __builtin_nontemporal_store(o, (GAS v4u*)(dst + (size_t)t * 8));
    }
    __device__ __forceinline__ bool step_emit(int tid, bool emitter) {
        if (i0 < 0) return false;
        if (emitter) { bf16* d = dst_of(i0); emit(d, bi, tid); emit(d, bi, tid + 256); }
        i0 = -1; return true;
    }
    __device__ __forceinline__ bool step_load(int tid, bool issuer) {
        int ni = -1;
        if (idx < n) {
            ni = idx; ++idx;
            if (issuer) {
                const LAS unsigned* e = (const LAS unsigned*)(scr + (CVS_TAB - CVS_OFF)) + ni * 6;
                const unsigned s0 = __builtin_amdgcn_readfirstlane(e[0]), s1 = __builtin_amdgcn_readfirstlane(e[1]), rs = __builtin_amdgcn_readfirstlane(e[4]);
                const char* src = (const char*)(((unsigned long long)s1 << 32) | s0);
                const int lane = tid & 63, wq = __builtin_amdgcn_readfirstlane((tid >> 6) & 3);
                const char* lp = src + (unsigned)((8 * (lane & 7) + 2 * wq) * rs + 16 * (lane >> 3));
                LAS unsigned char* lb = scr + bi * 16384 + wq * 4096;
                __builtin_amdgcn_global_load_lds((const unsigned*)lp, (LAS unsigned*)lb, 16, 0, 2);
                __builtin_amdgcn_global_load_lds((const unsigned*)(lp + 128), (LAS unsigned*)(lb + 1024), 16, 0, 2);
                __builtin_amdgcn_global_load_lds((const unsigned*)(lp + rs), (LAS unsigned*)(lb + 2048), 16, 0, 2);
                __builtin_amdgcn_global_load_lds((const unsigned*)(lp + rs + 128), (LAS unsigned*)(lb + 3072), 16, 0, 2);
            }
        }
        i0 = i1; i1 = i2; i2 = ni; bi = bi == 2 ? 0 : bi + 1;
        return ni >= 0;
    }
    __device__ __forceinline__ void flush(int tid) {
        asm volatile("s_waitcnt vmcnt(0)" ::: "memory"); __syncthreads();
        if (i0 >= 0) emit(dst_of(i0), bi, tid);
        if (i1 >= 0) emit(dst_of(i1), bi == 2 ? 0 : bi + 1, tid);
        if (i2 >= 0) emit(dst_of(i2), bi == 0 ? 2 : bi - 1, tid);
        i0 = -1; i1 = -1; i2 = -1;
    }
};
static_assert((CV_A7 + 255) / 256 <= CVS_MAXN && (CV_A20 + 255) / 256 <= CVS_MAXN, "attention side stream: the item table of one workgroup fits its LDS slot");
__device__ __forceinline__ void attn_even_phase(const Args& a, unsigned char* lds_g, LAS unsigned char* lds, int c, int G, int tid) {
    unsigned char* ws = a.ws; const bf16* QB = (const bf16*)(ws + WS_QB); const bf16* KN = (const bf16*)(ws + WS_KN); const bf16* VN = (const bf16*)(ws + WS_VN);
    const bf16* KG = (const bf16*)(ws + WS_KG); const bf16* PV = (const bf16*)(ws + WS_P); bf16* AO = (bf16*)(ws + WS_AO);
    const int wave = tid >> 6, lane = tid & 63;
    LAS float* rpbS = (LAS float*)(lds + att::Cfg<128>::SHM_RPB);
    CvSide sd; sd.init(a, lds, CV_S7, CV_A7, c, G, tid);
    for (int gi = c; gi < 1088; gi += G) {
        const bf16 *Qp, *Kp, *Vp; bf16* Op; int ldk, NT, seg2 = 0, bb; att::NaWave nw; nw.na = 0; nw.r0w = 0; nw.rq = 0; nw.cq = 0; nw.c0 = 0; nw.rlo = 0; nw.rpb = rpbS;
        if (gi < 512) {
            const int xg = gi & 7, u = gi >> 3, b = xg >> 2, kvh = xg & 3, h = kvh * 4 + (u >> 4), qb = u & 15;
            const size_t qrow = (size_t)b * SEQ + qb * 256;
            Qp = QB + qrow * DM + 2048 + h * 128; Op = AO + qrow * DM + 2048 + h * 128; Kp = KG + (size_t)b * NKEY * 512 + kvh * 128; Vp = PV + 17 * 512 + kvh * 128; ldk = 512; NT = NKEY / 64; bb = b;
        } else if (gi < 1024) {
            const int L = gi - 512, xg = L & 7, u = L >> 3, pair = xg * 4 + (u >> 4), Rg = u & 15, b = pair >> 4, h = pair & 15;
            const size_t qrow = (size_t)b * SEQ + Rg * 256;
            Qp = QB + qrow * DM + h * 128; Op = AO + qrow * DM + h * 128; Kp = KN + (size_t)b * NKEY * 2048 + h * 128; Vp = PV + 12 * 512 + h * 128; ldk = 2048; bb = b;
            const int rlo = min(max(4 * Rg - 4, 0), 56), nb = (Rg == 0 || Rg == 15) ? 8 : 12;
            NT = 4 + nb; seg2 = rlo * 64;
            const int rq = 4 * Rg + (wave >> 1), cq = (wave & 1) * 32 + (lane & 31);
            nw.na = 1; nw.rq = rq; nw.r0w = min(max(rq - 4, 0), 56); nw.cq = cq; nw.c0 = min(max(cq - 8, 0), 48); nw.rlo = rlo;
            __syncthreads();
            if (tid < 465) rpbS[tid] = a.in[13][h * 465 + tid] * (1.0f / att::Cfg<128>::SCALE);
        } else {
            const int L = gi - 1024, ty = L >> 5, b = (L >> 4) & 1, h = L & 15;
            const size_t qrow = (size_t)NLAT + b * CTXL;
            if (ty == 0) { Qp = QB + qrow * DM + h * 128; Op = AO + qrow * DM + h * 128; Kp = KN + (size_t)b * NKEY * 2048 + h * 128; Vp = PV + 12 * 512 + h * 128; ldk = 2048; }
            else { Qp = QB + qrow * DM + 2048 + h * 128; Op = AO + qrow * DM + 2048 + h * 128; Kp = KG + (size_t)b * NKEY * 512 + (h >> 2) * 128; Vp = PV + 17 * 512 + (h >> 2) * 128; ldk = 512; }
            NT = 4; bb = b;
        }
        att::attn_body<128, true, CvSide>(Qp, DM, Kp, ldk, Vp, EVN, Op, DM, NT, seg2, NLAT + bb * CTXL, bb * SEQ - CTXL, nw, (char*)lds_g, sd);
    }
    sd.flush(tid);
}
__device__ __forceinline__ void attn_mla_phase(const Args& a, unsigned char* lds_g, LAS unsigned char* lds, int c, int G) {
    unsigned char* ws = a.ws; const bf16* QM = (const bf16*)(ws + WS_QM); const bf16* KM = (const bf16*)(ws + WS_KM); const bf16* KVR = (const bf16*)(ws + WS_KVRAW); bf16* AO = (bf16*)(ws + WS_AO);
    att::NaWave nw; nw.na = 0; nw.r0w = 0; nw.rq = 0; nw.cq = 0; nw.c0 = 0; nw.rlo = 0; nw.rpb = nullptr;
    CvSide sd; sd.init(a, lds, CV_S20, CV_A20, c, G, (int)threadIdx.x);
    for (int gi = c; gi < 1024; gi += G) {
        const int xg = gi & 7, u = gi >> 3, pair = xg * 8 + (u >> 4), qb = u & 15, b = pair >> 5, h = pair & 31;
        const size_t qrow = (size_t)b * SEQ + qb * 256;
        att::attn_body<192, false, CvSide>(QM + qrow * UQN + h * 192, UQN, KM + (size_t)b * NKEY * UQN + h * 192, UQN, KVR + h * 256 + 128, UKVN, AO + qrow * DM + h * 128, DM, NKEY / 64, 0, NLAT + b * CTXL, b * SEQ - CTXL, nw, (char*)lds_g, sd);
    }
    sd.flush((int)threadIdx.x);
}
constexpr int NPHASE = 25;
__global__ void __launch_bounds__(NWAVES * 64, 2) fwd_kernel(Args args) {
    extern __shared__ __attribute__((aligned(16))) unsigned char lds_g[];
    LAS unsigned char* lds = (LAS unsigned char*)lds_g;
    const int tid = threadIdx.x, lane = tid & 63, wave = __builtin_amdgcn_readfirstlane(tid >> 6);
    const int G = gridDim.x, c = blockIdx.x;
    const int vcu = (G % 8 == 0) ? (c % 8) * (G / 8) + c / 8 : c;
    const int gw = vcu * NWAVES + wave, NGW = G * NWAVES;
    unsigned char* ws = args.ws;
    volatile LAS unsigned* MISC = (volatile LAS unsigned*)(lds + MISC_OFF);
    for (int u = tid; u < (LDS_BYTES - LDSCTL_OFF) / 4; u += NWAVES * 64) ((LAS unsigned*)(lds + LDSCTL_OFF))[u] = 0u;
    __syncthreads();
    XcdBarrier bar; bar.bar = (unsigned*)(ws + WS_CTL) + CW_BAR; bar.x = 0; bar.st = nullptr;
    if (ONE_LAUNCH) bar = xcd_barrier_post((unsigned*)(ws + WS_CTL) + CW_BAR, MISC + 8);
    const int lo = args.ph_lo, hi = args.ph_hi;
#define IN(k) (lo <= (k) && (k) < hi)
#define PH_BEGIN(k) if (IN(k))
    constexpr int FFN1_NMAJ = 4, INP_NMAJ = 0, RES_NMAJ = 0;
#define SEAM(k) do { if (ONE_LAUNCH && IN(k) && IN((k) + 1)) xcd_barrier(bar); } while (0)
    float* MOD = (float*)(ws + WS_MOD);
    bf16* U = (bf16*)(ws + WS_U); bf16* HID = (bf16*)(ws + WS_HID); bf16* AO = (bf16*)(ws + WS_AO);
    float* HA = (float*)(ws + WS_HA); float* HB = (float*)(ws + WS_HB);
    const float* X = args.in[0]; const float* CTXI = args.in[2]; const float* NG = args.in[4];
    const float* MOD0 = MOD; const float* MOD1 = MOD + 3 * NMOD * DM;
    float* SLAB = (float*)(ws + WS_SLAB); const float* NOSLAB = nullptr;
    const float* GC0 = MOD0 + (size_t)2 * NMOD * DM; const float* GC1 = MOD1 + (size_t)2 * NMOD * DM;

#define PH_MODULATE(k, srcl, srcc, gptr, modl, ish, isc, Mrows, slabp, sgatep, gsv, houtc) PH_BEGIN(k) { modulate_phase(srcl, srcc, gptr, modl, ish, isc, U, Mrows, gw, NGW, lane, slabp, sgatep, gsv, houtc, lds); } SEAM(k);
#define PH_FFN1(k, widx, Mrows, cvfirst, cvcount) PH_BEGIN(k) { pg8::Gemm g{U, (const bf16*)(ws + WS_WT1 + (size_t)(widx) * WT1_SZ), Mrows, 2 * DFF, DM, DM, 0}; pg8::StaticOrder S; S.init(Mrows, 2 * DFF, G, c, DM, FFN1_NMAJ); \
        pg8::EpiSwiglu E{HID, DFF}; pg8::gemm_phase<pg8::EpiSwiglu, pg8::StaticOrder, PG8_ALIGN, PG8_SP2>(lds, g, S, E); \
        if ((cvcount) > 0) tail_convert(args, lds, ((Mrows) / 256) * (2 * DFF / 256), G, c, cvfirst, cvcount, wave, lane); } SEAM(k);
#define PH_RESID(k, Aptr, Wptr, Kdim, Mrows, rl, rc, outp, gatep, gsv) PH_BEGIN(k) { pg8::Gemm g{Aptr, (const bf16*)(Wptr), Mrows, DM, Kdim, Kdim, 0}; pg8::StaticOrder S; S.init(Mrows, DM, G, c, Kdim, RES_NMAJ); \
        pg8::EpiResid E{rl, rc, outp, gatep, gsv}; pg8::gemm_phase<pg8::EpiResid, pg8::StaticOrder, PG8_ALIGN, PG8_SP2>(lds, g, S, E); } SEAM(k);
#define PH_RESID_SPLIT(k, Aptr, Wptr, Kdim, rl, rc, outp, gatep, gsv) PH_BEGIN(k) { pg8::Gemm g{Aptr, (const bf16*)(Wptr), MROWS, DM, Kdim, Kdim, 0}; pg8::SplitOrder S; S.init(G, c, Kdim); \
        pg8::EpiResidSplit E{{rl, rc, outp, gatep, gsv}, SLAB}; pg8::gemm_phase<pg8::EpiResidSplit, pg8::SplitOrder, PG8_ALIGN, PG8_SP2>(lds, g, S, E); } SEAM(k);

    PH_BEGIN(0) { p0_convert(args, lds, 0, CV_P0, gw, NGW, wave, lane); p0_zero_pad(args, c, G, tid); __syncthreads(); p0_mod(args, lds, c, G, tid); } SEAM(0);

    PH_MODULATE(1, X, CTXI, NG + 0 * DM, MOD0, 0, 1, MROWS, NOSLAB, NOSLAB, 0.f, (float*)nullptr)
    PH_FFN1(2, 0, MROWS, CV_S2, CV_T2)
    PH_RESID_SPLIT(3, HID, ws + WS_WT2 + 0 * WT2_SZ, DFF, X, CTXI, HA, MOD0 + 2 * DM, 0.5f)
    PH_MODULATE(4, HA, CTXI, NG + 1 * DM, MOD0, 3, 4, MROWS, SLAB, GC0 + 2 * DM, 0.5f, HA + (size_t)NLAT * DM)
    PH_BEGIN(5) { pg8::Gemm g{U, (const bf16*)(ws + WS_WIN), MROWS, EVN, DM, DM, 0}; pg8::StaticOrder S; S.init(MROWS, EVN, G, c, DM, INP_NMAJ);
        pg8::EpiBf16P E{(bf16*)(ws + WS_P), EVN}; pg8::gemm_phase<pg8::EpiBf16P, pg8::StaticOrder, PG8_ALIGN, PG8_SP2>(lds, g, S, E);
        tail_convert(args, lds, (MROWS / 256) * (EVN / 256), G, c, CV_S5, CV_T5, wave, lane); } SEAM(5);
    PH_BEGIN(6) { prep_even_phase(args, gw, NGW, lane); } SEAM(6);
    PH_BEGIN(7) { attn_even_phase(args, lds_g, lds, c, G, tid); } SEAM(7);
    PH_RESID_SPLIT(8, AO, ws + WS_WOUT, DM, HA, HA + (size_t)NLAT * DM, HB, MOD0 + 5 * DM, 1.0f)
    PH_MODULATE(9, HB, HA + (size_t)NLAT * DM, NG + 2 * DM, MOD0, 6, 7, MROWS, SLAB, GC0 + 5 * DM, 1.0f, HB + (size_t)NLAT * DM)
    PH_FFN1(10, 1, MROWS, CV_S10, CV_T10)
    PH_RESID_SPLIT(11, HID, ws + WS_WT2 + 1 * WT2_SZ, DFF, HB, HB + (size_t)NLAT * DM, HA, MOD0 + 8 * DM, 0.5f)

    PH_MODULATE(12, HA, HB + (size_t)NLAT * DM, NG + 3 * DM, MOD1, 0, 1, MROWS, SLAB, GC0 + 8 * DM, 0.5f, HA + (size_t)NLAT * DM)
    PH_FFN1(13, 2, MROWS, CV_S13, CV_T13)
    PH_RESID_SPLIT(14, HID, ws + WS_WT2 + 2 * WT2_SZ, DFF, HA, HA + (size_t)NLAT * DM, HB, MOD1 + 2 * DM, 0.5f)
    PH_MODULATE(15, HB, HA + (size_t)NLAT * DM, NG + 4 * DM, MOD1, 3, 4, MROWS, SLAB, GC1 + 2 * DM, 0.5f, HB + (size_t)NLAT * DM)
    PH_BEGIN(16) { pg8::Gemm g{U, (const bf16*)(ws + WS_WDOWN), MROWS, DLN, DM, DM, 0}; pg8::StaticOrder S; S.init(MROWS, DLN, G, c, DM);
        pg8::EpiF32P E{(float*)(ws + WS_DL), DLN}; pg8::gemm_phase<pg8::EpiF32P, pg8::StaticOrder, PG8_ALIGN, PG8_SP2>(lds, g, S, E);
        tail_convert(args, lds, (MROWS / 256) * (DLN / 256), G, c, CV_S16, CV_T16, wave, lane); } SEAM(16);
    PH_BEGIN(17) { prep_mla1_phase(args, gw, NGW, lane); } SEAM(17);
    PH_BEGIN(18) {
        { pg8::Gemm g{(const bf16*)(ws + WS_CQN), (const bf16*)(ws + WS_WUQ), NLAT, UQN, 1024, 1024, 0}; pg8::StaticOrder S; S.init(NLAT, UQN, G, c, 1024);
          pg8::EpiBf16P E{(bf16*)(ws + WS_QRAW), UQN}; pg8::gemm_phase<pg8::EpiBf16P, pg8::StaticOrder, PG8_ALIGN, PG8_SP2>(lds, g, S, E); }
        { pg8::Gemm g{(const bf16*)(ws + WS_CKVN), (const bf16*)(ws + WS_WUKV), MROWS, UKVN, 512, 512, 0}; pg8::StaticOrder S; S.init(MROWS, UKVN, G, c, 512);
          pg8::EpiBf16P E{(bf16*)(ws + WS_KVRAW), UKVN}; pg8::gemm_phase<pg8::EpiBf16P, pg8::StaticOrder, PG8_ALIGN, PG8_SP2>(lds, g, S, E); }
        tail_convert(args, lds, (MROWS / 256) * (UKVN / 256), G, c, CV_S18, CV_T18, wave, lane);
    } SEAM(18);
    PH_BEGIN(19) { prep_mla2_phase(args, gw, NGW, lane); } SEAM(19);
    PH_BEGIN(20) { attn_mla_phase(args, lds_g, lds, c, G); } SEAM(20);
    PH_RESID(21, AO, ws + WS_WO, DM, NLAT, HB, HB, HA, MOD1 + 5 * DM, 1.0f)
    PH_MODULATE(22, HA, HA, NG + 5 * DM, MOD1, 6, 7, NLAT, NOSLAB, NOSLAB, 0.f, (float*)nullptr)
    PH_FFN1(23, 3, NLAT, 0, 0)
    PH_RESID(24, HID, ws + WS_WT2 + 3 * WT2_SZ, DFF, NLAT, HA, HA, args.out, MOD1 + 8 * DM, 0.5f)
#undef IN
#undef SEAM
}

extern "C" void kernel_launch(void* const* d_in, const int* in_sizes, int n_in, void* d_out, int out_size, void* d_ws, size_t ws_size, hipStream_t stream) {
    static int grid = 0;
    if (grid == 0) {
        if (n_in != 26 || out_size != NLAT * DM || ws_size < WS_END) { fprintf(stderr, "kernel_launch: unexpected shapes (n_in %d out %d ws %zu)\n", n_in, out_size, ws_size); grid = -1; return; }
        int dev = 0, cus = 0, per_cu = 0;
        if (hipGetDevice(&dev) != hipSuccess || hipDeviceGetAttribute(&cus, hipDeviceAttributeMultiprocessorCount, dev) != hipSuccess) { grid = -1; return; }
        if (hipFuncSetAttribute((const void*)fwd_kernel, hipFuncAttributeMaxDynamicSharedMemorySize, LDS_BYTES) != hipSuccess) { fprintf(stderr, "kernel_launch: hipFuncSetAttribute failed\n"); grid = -1; return; }
        if (hipOccupancyMaxActiveBlocksPerMultiprocessor(&per_cu, (const void*)fwd_kernel, NWAVES * 64, LDS_BYTES) != hipSuccess || per_cu < 1) { fprintf(stderr, "kernel_launch: occupancy query reports %d\n", per_cu); }
        (void)hipGetLastError();
        grid = cus;
    }
    if (grid < 0) return;
    (void)hipMemsetAsync((char*)d_ws + WS_CTL, 0, CTL_ZERO_BYTES, stream);
    Args a{};
    for (int i = 0; i < 26; ++i) a.in[i] = (const float*)d_in[i];
    a.out = (float*)d_out; a.ws = (unsigned char*)d_ws; a.chk = 0; a.pad = 0;
#if DBG
    (void)hipMemsetAsync((char*)d_ws + WS_DBG, 0, 4096, stream);
#define DBG_STEP(K) a.ph_lo = K; a.ph_hi = K + 1; hipLaunchKernelGGL(fwd_kernel, dim3(grid), dim3(NWAVES * 64), LDS_BYTES, stream, a); hipLaunchKernelGGL(check_kernel<K>, dim3(256), dim3(256), 0, stream, a);
    DBG_STEP(0) DBG_STEP(1) DBG_STEP(2) DBG_STEP(3) DBG_STEP(4) DBG_STEP(5) DBG_STEP(6) DBG_STEP(7) DBG_STEP(8) DBG_STEP(9) DBG_STEP(10) DBG_STEP(11) DBG_STEP(12)
    DBG_STEP(13) DBG_STEP(14) DBG_STEP(15) DBG_STEP(16) DBG_STEP(17) DBG_STEP(18) DBG_STEP(19) DBG_STEP(20) DBG_STEP(21) DBG_STEP(22) DBG_STEP(23) DBG_STEP(24)
    hipLaunchKernelGGL(dbg_sanitize, dim3(1024), dim3(256), 0, stream, a);
    hipLaunchKernelGGL(dbg_encode, dim3(1), dim3(64), 0, stream, a);
#elif ONE_LAUNCH
    a.ph_lo = 0; a.ph_hi = NPHASE;
    hipLaunchKernelGGL(fwd_kernel, dim3(grid), dim3(NWAVES * 64), LDS_BYTES, stream, a);
#else
    for (int k = 0; k < NPHASE; ++k) { a.ph_lo = k; a.ph_hi = k + 1; hipLaunchKernelGGL(fwd_kernel, dim3(grid), dim3(NWAVES * 64), LDS_BYTES, stream, a); }
#endif
}
```

```cpp
#define DBG 0
#define ONE_LAUNCH 1
#include <hip/hip_runtime.h>
#include <cstdio>
#include <cstdint>
#ifndef DBG
#define DBG 0
#endif
#ifndef ONE_LAUNCH
#define ONE_LAUNCH 1
#endif
#ifndef PG8_SP2
#define PG8_SP2 true
#endif
#ifndef PG8_ALIGN
#define PG8_ALIGN true
#endif
namespace pg8 {
#define PG8_LAS __attribute__((address_space(3)))
typedef unsigned short bf16_t;
typedef short bf16x8 __attribute__((ext_vector_type(8)));
typedef float f32x4 __attribute__((ext_vector_type(4)));
typedef unsigned u32x4 __attribute__((ext_vector_type(4)));
constexpr int BM = 256, BK = 64, HALF = 128, HTB = HALF * BK * 2  , STAGE_BYTES = 8 * HTB, NXCD = 8;
#ifndef PG8_WGM
#define PG8_WGM 8
#endif
constexpr int WGM = PG8_WGM;

__host__ __device__ __forceinline__ int lds_byte(int r, int c) { const int st = (r >> 4) * 2 + (c >> 5), rr = r & 15, cc = c & 31, ob = rr * 64 + cc * 2; return st * 1024 + (ob ^ (((ob >> 9) & 1) << 5)); }
__host__ __device__ __forceinline__ void stage_rc(int b, int& R, int& C) { const int st = b / 1024, sb = b % 1024, swz = sb ^ (((sb >> 9) & 1) << 5); R = (st >> 1) * 16 + swz / 64; C = (st & 1) * 32 + (swz % 64) / 2; }
__host__ __device__ __forceinline__ int perm32(int rho) { const int n = rho >> 4, i = rho & 15; return 8 * (i >> 2) + 4 * n + (i & 3); }

struct Unit { int pm, pn, k0, nt, sp, idx; };
struct Gemm { const bf16_t* A; const bf16_t* Bt; int M, N, K, lda, ldb; };

struct StaticOrder {
    int nM, nN, nwg, G, c, ntk, nmaj;
    __host__ __device__ void init(int M, int N, int G_, int c_, int K_, int nmaj_ = 0) { nM = M / BM; nN = N / BM; nwg = nM * nN; G = G_; c = c_; ntk = K_ / BK; nmaj = nmaj_; }
    __host__ __device__ __forceinline__ void map(int wgid, int& pm, int& pn) const {
        { const int q = nwg / NXCD, r = nwg % NXCD, xcd = wgid % NXCD, off = wgid / NXCD; wgid = (xcd < r ? xcd * (q + 1) : r * (q + 1) + (xcd - r) * q) + off; }
        if (nmaj > 0) { const int nig = nmaj * nM, gid = wgid / nig, fn = gid * nmaj, gsz = (nN - fn) < nmaj ? (nN - fn) : nmaj; pn = fn + ((wgid % nig) % gsz); pm = (wgid % nig) / gsz; return; }
        const int nig = WGM * nN, gid = wgid / nig, fm = gid * WGM, gsz = (nM - fm) < WGM ? (nM - fm) : WGM;
        pm = fm + ((wgid % nig) % gsz); pn = (wgid % nig) / gsz;
    }
    __host__ __device__ __forceinline__ bool next(int i, Unit& u) const {
        const long L = (long)i * G + c; if (L >= nwg) return false;
        int pm, pn; map((int)L, pm, pn); u.pm = pm; u.pn = pn; u.k0 = 0; u.nt = ntk; u.sp = -1; u.idx = i; return true;
    }
    __device__ __forceinline__ void a_ready(const Unit&) const {}
    __device__ __forceinline__ void done(const Unit&) const {}
};
__device__ __forceinline__ unsigned cvt_pk_bf16(float lo, float hi) { unsigned r; asm volatile("v_cvt_pk_bf16_f32 %0, %1, %2" : "=v"(r) : "v"(lo), "v"(hi)); return r; }
typedef float f32x2 __attribute__((ext_vector_type(2)));
template <class Epi, class Sched, bool ALIGN_EPI = false, bool SP2 = false>
__device__ __forceinline__ void gemm_phase(PG8_LAS unsigned char* lds, const Gemm g, const Sched& S, const Epi& E) {
    const int tid = threadIdx.x, wid = __builtin_amdgcn_readfirstlane(tid >> 6), lane = tid & 63, wr = wid >> 2, wc = wid & 3, fr = lane & 15, fq = lane >> 4;
    const int K = g.K;
    unsigned voffA[2], voffB[2];
#pragma unroll
    for (int i = 0; i < 2; ++i) { int R, C; stage_rc(tid * 16 + i * 8192, R, C); const int Rb = Epi::PERM ? ((R & ~31) + perm32(R & 31)) : R;
        voffA[i] = (unsigned)(R * g.lda + C) * 2u; voffB[i] = (unsigned)(Rb * (g.ldb ? g.ldb : BK) + C) * 2u; }
    const size_t kstepA = (size_t)(BK * 2), kstepB = g.ldb ? (size_t)(BK * 2) : (size_t)(BM * BK * 2);
    const size_t hstepA = (size_t)HALF * g.lda * 2, hstepB = g.ldb ? (size_t)HALF * g.ldb * 2 : (size_t)HALF * BK * 2;
    const size_t tstepA = 2 * hstepA, tstepB = g.ldb ? 2 * hstepB : (size_t)BM * K * 2;
    const unsigned ldsw = (unsigned)wid * 1024u;
    const int aoff = lds_byte(wr * 64 + fr, fq * 8), boff = lds_byte(wc * 32 + fr, fq * 8);
#define PG8_SA(b, h) (((b) * 2 + (h)) * HTB)
#define PG8_SB(b, h) ((4 + (b) * 2 + (h)) * HTB)
#define PG8_STAGE(bufoff, gbase, voff) do { _Pragma("unroll") for (int _i = 0; _i < 2; ++_i) \
        __builtin_amdgcn_global_load_lds((const unsigned*)((const char*)(gbase) + (voff)[_i]), (PG8_LAS unsigned*)(lds + (bufoff) + ldsw + _i * 8192), 16, 0, 0); } while (0)
#define PG8_LDA(dst, b, h) do { _Pragma("unroll") for (int m = 0; m < 4; ++m) _Pragma("unroll") for (int k = 0; k < 2; ++k) dst[m][k] = *(const PG8_LAS bf16x8*)(lds + PG8_SA(b, h) + aoff + m * 2048 + k * 1024); } while (0)
#define PG8_LDB(dst, b, h) do { _Pragma("unroll") for (int n = 0; n < 2; ++n) _Pragma("unroll") for (int k = 0; k < 2; ++k) dst[n][k] = *(const PG8_LAS bf16x8*)(lds + PG8_SB(b, h) + boff + n * 2048 + k * 1024); } while (0)
#define PG8_MMA(ai, bj, At, Bt) do { __builtin_amdgcn_s_setprio(1); _Pragma("unroll") for (int m = 0; m < 4; ++m) _Pragma("unroll") for (int n = 0; n < 2; ++n) _Pragma("unroll") for (int k = 0; k < 2; ++k) \
        acc[ai][bj][m][n] = __builtin_amdgcn_mfma_f32_16x16x32_bf16(Bt[n][k], At[m][k], acc[ai][bj][m][n], 0, 0, 0); __builtin_amdgcn_s_setprio(0); } while (0)
#define PG8_WAIT_V(n) asm volatile("s_waitcnt vmcnt(" #n ")" ::: "memory")
#define PG8_WAIT_L(n) asm volatile("s_waitcnt lgkmcnt(" #n ")" ::: "memory")
#define PG8_BAR __builtin_amdgcn_s_barrier()
#define PG8_SCHED __builtin_amdgcn_sched_barrier(0)
    Unit cur, nxt; int ui = 0;
    if (!S.next(0, cur)) return;
    f32x4 acc[2][2][4][2];
#pragma unroll
    for (int a = 0; a < 2; ++a)
#pragma unroll
        for (int b = 0; b < 2; ++b)
#pragma unroll
            for (int m = 0; m < 4; ++m)
#pragma unroll
                for (int n = 0; n < 2; ++n) acc[a][b][m][n] = (f32x4){0.f, 0.f, 0.f, 0.f};
    bf16x8 At[4][2], B0[2][2], B1[2][2];
    const char* cA = (const char*)g.A + (size_t)cur.pm * tstepA + (size_t)cur.k0 * kstepA; const char* cB = (const char*)g.Bt + (size_t)cur.pn * tstepB + (size_t)cur.k0 * kstepB;
    S.a_ready(cur);
    if constexpr (SP2) {
        PG8_STAGE(PG8_SB(0, 0), cB, voffB); PG8_STAGE(PG8_SB(0, 1), cB + hstepB, voffB); PG8_STAGE(PG8_SA(0, 0), cA, voffA); PG8_STAGE(PG8_SA(0, 1), cA + hstepA, voffA);
        if (wr == 1) PG8_BAR;
        PG8_WAIT_V(2); PG8_BAR;
        PG8_STAGE(PG8_SB(1, 0), cB + kstepB, voffB); PG8_STAGE(PG8_SA(1, 0), cA + kstepA, voffA); PG8_STAGE(PG8_SB(1, 1), cB + hstepB + kstepB, voffB);
        PG8_WAIT_V(6); PG8_BAR;
    } else {
        PG8_STAGE(PG8_SB(0, 0), cB, voffB); PG8_STAGE(PG8_SA(0, 0), cA, voffA); PG8_STAGE(PG8_SB(0, 1), cB + hstepB, voffB); PG8_STAGE(PG8_SA(0, 1), cA + hstepA, voffA);
        if (wr == 1) PG8_BAR;
        PG8_WAIT_V(4); PG8_BAR;
        PG8_STAGE(PG8_SB(1, 0), cB + kstepB, voffB); PG8_STAGE(PG8_SA(1, 0), cA + kstepA, voffA); PG8_STAGE(PG8_SB(1, 1), cB + hstepB + kstepB, voffB);
        PG8_WAIT_V(6); PG8_BAR;
    }
    for (;;) {
        const bool has_next = S.next(ui + 1, nxt);
        const char* nA = has_next ? (const char*)g.A + (size_t)nxt.pm * tstepA + (size_t)nxt.k0 * kstepA : cA; const char* nB = has_next ? (const char*)g.Bt + (size_t)nxt.pn * tstepB + (size_t)nxt.k0 * kstepB : cB;
        const int nt = cur.nt;
        for (int t = 0; t < nt; t += 2) {
            const bool last = (t == nt - 2);
            const char* a1 = cA + (size_t)(t + 1) * kstepA;
            const char* a2 = last ? nA : cA + (size_t)(t + 2) * kstepA; const char* b2 = last ? nB : cB + (size_t)(t + 2) * kstepB;
            const char* a3 = a2 + kstepA; const char* b3 = b2 + kstepB;
            if (last && has_next) S.a_ready(nxt);
            if constexpr (SP2) {
            PG8_LDB(B0, 0, 0); PG8_LDB(B1, 0, 1); PG8_SCHED; PG8_LDA(At, 0, 0); PG8_STAGE(PG8_SA(1, 1), a1 + hstepA, voffA);
            PG8_WAIT_V(8); PG8_WAIT_L(0); PG8_BAR; PG8_MMA(0, 0, At, B0); PG8_MMA(0, 1, At, B1); PG8_BAR; PG8_SCHED;
            PG8_LDA(At, 0, 1); PG8_STAGE(PG8_SB(0, 0), b2, voffB); PG8_STAGE(PG8_SB(0, 1), b2 + hstepB, voffB); PG8_STAGE(PG8_SA(0, 0), a2, voffA);
            PG8_WAIT_V(8); PG8_WAIT_L(0); PG8_BAR; PG8_MMA(1, 0, At, B0); PG8_MMA(1, 1, At, B1); PG8_BAR; PG8_SCHED;
            PG8_LDB(B0, 1, 0); PG8_LDB(B1, 1, 1); PG8_SCHED; PG8_LDA(At, 1, 0); PG8_STAGE(PG8_SA(0, 1), a2 + hstepA, voffA);
            PG8_WAIT_V(8); PG8_WAIT_L(0); PG8_BAR; PG8_MMA(0, 0, At, B0); PG8_MMA(0, 1, At, B1); PG8_BAR; PG8_SCHED;
            PG8_LDA(At, 1, 1); PG8_STAGE(PG8_SB(1, 0), b3, voffB); PG8_STAGE(PG8_SB(1, 1), b3 + hstepB, voffB); PG8_STAGE(PG8_SA(1, 0), a3, voffA);
            PG8_WAIT_V(8); PG8_WAIT_L(0); PG8_BAR; PG8_MMA(1, 0, At, B0); PG8_MMA(1, 1, At, B1); PG8_BAR; PG8_SCHED;
            } else {
            PG8_LDB(B0, 0, 0); PG8_SCHED; PG8_LDA(At, 0, 0); PG8_STAGE(PG8_SA(1, 1), a1 + hstepA, voffA);
            PG8_WAIT_L(8); PG8_BAR; PG8_WAIT_L(0); PG8_MMA(0, 0, At, B0); PG8_BAR; PG8_SCHED;
            PG8_LDB(B1, 0, 1); PG8_STAGE(PG8_SB(0, 0), b2, voffB);
            PG8_BAR; PG8_WAIT_L(0); PG8_MMA(0, 1, At, B1); PG8_BAR;
            PG8_LDA(At, 0, 1); PG8_STAGE(PG8_SA(0, 0), a2, voffA);
            PG8_BAR; PG8_WAIT_L(0); PG8_MMA(1, 0, At, B0); PG8_BAR; PG8_SCHED;
            PG8_STAGE(PG8_SB(0, 1), b2 + hstepB, voffB);
            PG8_WAIT_V(6); PG8_BAR; PG8_MMA(1, 1, At, B1); PG8_BAR;
            PG8_LDB(B0, 1, 0); PG8_SCHED; PG8_LDA(At, 1, 0); PG8_STAGE(PG8_SA(0, 1), a2 + hstepA, voffA);
            PG8_WAIT_L(8); PG8_BAR; PG8_WAIT_L(0); PG8_MMA(0, 0, At, B0); PG8_BAR; PG8_SCHED;
            PG8_LDB(B1, 1, 1); PG8_STAGE(PG8_SB(1, 0), b3, voffB);
            PG8_BAR; PG8_WAIT_L(0); PG8_MMA(0, 1, At, B1); PG8_BAR;
            PG8_LDA(At, 1, 1); PG8_STAGE(PG8_SA(1, 0), a3, voffA);
            PG8_BAR; PG8_WAIT_L(0); PG8_MMA(1, 0, At, B0); PG8_BAR; PG8_SCHED;
            PG8_STAGE(PG8_SB(1, 1), b3 + hstepB, voffB);
            PG8_WAIT_V(6); PG8_BAR; PG8_MMA(1, 1, At, B1); PG8_BAR;
            }
        }
        if constexpr (ALIGN_EPI) { if (wr == 0) PG8_BAR; }
        if constexpr (!Epi::AFTER_DRAIN) { E(acc, cur, wr, wc, fr, fq); S.done(cur); }
        if (!has_next) break;
#pragma unroll
        for (int a = 0; a < 2; ++a)
#pragma unroll
            for (int b = 0; b < 2; ++b)
#pragma unroll
                for (int m = 0; m < 4; ++m)
#pragma unroll
                    for (int n = 0; n < 2; ++n) acc[a][b][m][n] = (f32x4){0.f, 0.f, 0.f, 0.f};
        cur = nxt; cA = nA; cB = nB; ++ui;
        if constexpr (ALIGN_EPI) { if (wr == 1) PG8_BAR; }
    }
    PG8_WAIT_V(0);
    if constexpr (!ALIGN_EPI) { if (wr == 0) PG8_BAR; }
    PG8_BAR;
    if constexpr (Epi::AFTER_DRAIN) { E.fused(acc, cur, wr, wc, fr, fq, lds, wid, lane); S.done(cur); }
#undef PG8_SA
#undef PG8_SB
#undef PG8_STAGE
#undef PG8_LDA
#undef PG8_LDB
#undef PG8_MMA
#undef PG8_WAIT_V
#undef PG8_WAIT_L
#undef PG8_BAR
#undef PG8_SCHED
}
struct EpiBf16P {
    static constexpr bool PERM = true, AFTER_DRAIN = false;
    bf16_t* O; int ldc;
    __device__ __forceinline__ void operator()(const f32x4 (&acc)[2][2][4][2], const Unit& u, int wr, int wc, int fr, int fq) const {
        const int row0 = u.pm * BM + wr * 64 + fr, col0 = u.pn * BM + wc * 32 + 8 * fq;
#pragma unroll
        for (int ai = 0; ai < 2; ++ai)
#pragma unroll
            for (int m = 0; m < 4; ++m) { bf16_t* rowp = O + (size_t)(row0 + ai * HALF + m * 16) * ldc + col0;
#pragma unroll
                for (int bj = 0; bj < 2; ++bj) { const f32x4 v0 = acc[ai][bj][m][0], v1 = acc[ai][bj][m][1];
                    u32x4 w; w.x = cvt_pk_bf16(v0[0], v0[1]); w.y = cvt_pk_bf16(v0[2], v0[3]); w.z = cvt_pk_bf16(v1[0], v1[1]); w.w = cvt_pk_bf16(v1[2], v1[3]);
                    *(u32x4*)(rowp + bj * HALF) = w; } }
    }
};
struct EpiF32P {
    static constexpr bool PERM = false, AFTER_DRAIN = false;
    float* C; int ldc;
    __device__ __forceinline__ void operator()(const f32x4 (&acc)[2][2][4][2], const Unit& u, int wr, int wc, int fr, int fq) const {
        const int row0 = u.pm * BM + wr * 64 + fr, col0 = u.pn * BM + wc * 32 + 4 * fq;
#pragma unroll
        for (int ai = 0; ai < 2; ++ai)
#pragma unroll
            for (int m = 0; m < 4; ++m) { float* rowp = C + (size_t)(row0 + ai * HALF + m * 16) * ldc + col0;
#pragma unroll
                for (int bj = 0; bj < 2; ++bj)
#pragma unroll
                    for (int n = 0; n < 2; ++n) *(f32x4*)(rowp + bj * HALF + n * 16) = acc[ai][bj][m][n]; }
    }
};
__device__ __forceinline__ float silu_mul(float g, float u) { const float e = __builtin_amdgcn_exp2f(g * -1.4426950408889634f); return g * __builtin_amdgcn_rcpf(1.0f + e) * u; }
struct EpiSwiglu {
    static constexpr bool PERM = true, AFTER_DRAIN = false;
    bf16_t* O; int ldc;
    __device__ __forceinline__ void operator()(const f32x4 (&acc)[2][2][4][2], const Unit& u, int wr, int wc, int fr, int fq) const {
        const int row0 = u.pm * BM + wr * 64 + fr, col0 = u.pn * HALF + wc * 32 + 8 * fq;
#pragma unroll
        for (int ai = 0; ai < 2; ++ai)
#pragma unroll
            for (int m = 0; m < 4; ++m) { bf16_t* rowp = O + (size_t)(row0 + ai * HALF + m * 16) * ldc + col0;
                const f32x4 g0 = acc[ai][0][m][0], g1 = acc[ai][0][m][1], u0 = acc[ai][1][m][0], u1 = acc[ai][1][m][1];
                u32x4 w; w.x = cvt_pk_bf16(silu_mul(g0[0], u0[0]), silu_mul(g0[1], u0[1])); w.y = cvt_pk_bf16(silu_mul(g0[2], u0[2]), silu_mul(g0[3], u0[3]));
                w.z = cvt_pk_bf16(silu_mul(g1[0], u1[0]), silu_mul(g1[1], u1[1])); w.w = cvt_pk_bf16(silu_mul(g1[2], u1[2]), silu_mul(g1[3], u1[3]));
                *(u32x4*)rowp = w; }
    }
};
struct EpiResid {
    static constexpr bool PERM = false, AFTER_DRAIN = false;
    const float* res_lat; const float* res_ctx; float* out; const float* gate; float gs;
    __device__ __forceinline__ void operator()(const f32x4 (&acc)[2][2][4][2], const Unit& u, int wr, int wc, int fr, int fq) const {
        const int rt = wr * 64 + fr, col0 = u.pn * BM + wc * 32 + 4 * fq;
        const int vec = u.pm < 16 ? 0 : (u.pm < 32 ? 1 : 2);
        const float* rbase = (u.pm < 32 ? res_lat + (size_t)u.pm * BM * 4096 : res_ctx + (size_t)(u.pm - 32) * BM * 4096) + col0;
        float* obase = out + (size_t)u.pm * BM * 4096 + col0;
        const float* gp = gate + (size_t)vec * 9 * 4096 + col0;
        f32x4 gv[2][2];
#pragma unroll
        for (int bj = 0; bj < 2; ++bj)
#pragma unroll
            for (int n = 0; n < 2; ++n) gv[bj][n] = *(const f32x4*)(gp + bj * HALF + n * 16) * gs;
#pragma unroll
        for (int ai = 0; ai < 2; ++ai)
#pragma unroll
            for (int mp = 0; mp < 4; mp += 2) {
                f32x4 r[2][2][2];
#pragma unroll
                for (int m = 0; m < 2; ++m) { const size_t ro = (size_t)(rt + ai * HALF + (mp + m) * 16) * 4096;
#pragma unroll
                    for (int bj = 0; bj < 2; ++bj)
#pragma unroll
                        for (int n = 0; n < 2; ++n) r[m][bj][n] = *(const f32x4*)(rbase + ro + bj * HALF + n * 16); }
                __builtin_amdgcn_sched_barrier(0);
#pragma unroll
                for (int m = 0; m < 2; ++m) { const size_t ro = (size_t)(rt + ai * HALF + (mp + m) * 16) * 4096;
#pragma unroll
                    for (int bj = 0; bj < 2; ++bj)
#pragma unroll
                        for (int n = 0; n < 2; ++n) *(f32x4*)(obase + ro + bj * HALF + n * 16) = r[m][bj][n] + gv[bj][n] * acc[ai][bj][mp + m][n]; }
                __builtin_amdgcn_sched_barrier(0);
                asm volatile("" ::: "memory"); }
    }
};

struct SplitOrder {
    StaticOrder lat; int G, c, ntk;
    __host__ __device__ void init(int G_, int c_, int K_) { lat.init(8192, 4096, G_, c_, K_); G = G_; c = c_; ntk = K_ / BK; }
    __host__ __device__ __forceinline__ bool next(int i, Unit& u) const {
        const long L = (long)i * G + c; if (L >= 768) return false;
        const bool isl = L < 512; int pm, pn; lat.map(isl ? (int)L : 0, pm, pn);
        const int j = (int)(L - 512) & 255, sp = j & 7, tile = j >> 3, ntq = ntk / 8;
        u.pm = isl ? pm : 32 + (tile >> 4); u.pn = isl ? pn : (tile & 15); u.k0 = isl ? 0 : sp * ntq; u.nt = isl ? ntk : ntq; u.sp = isl ? -1 : sp; u.idx = i; return true;
    }
    __device__ __forceinline__ void a_ready(const Unit&) const {}
    __device__ __forceinline__ void done(const Unit&) const {}
};
struct EpiResidSplit {
    static constexpr bool PERM = false, AFTER_DRAIN = false;
    EpiResid r; float* slab;
    __device__ __forceinline__ void operator()(const f32x4 (&acc)[2][2][4][2], const Unit& u, int wr, int wc, int fr, int fq) const {
        if (u.sp < 0) { r(acc, u, wr, wc, fr, fq); return; }
        const int row0 = (u.pm - 32) * BM + wr * 64 + fr, col0 = u.pn * BM + wc * 32 + 4 * fq;
        float* base = slab + ((size_t)u.sp * 512 + row0) * 4096 + col0;
#pragma unroll
        for (int ai = 0; ai < 2; ++ai)
#pragma unroll
            for (int m = 0; m < 4; ++m) { float* rowp = base + (size_t)(ai * HALF + m * 16) * 4096;
#pragma unroll
                for (int bj = 0; bj < 2; ++bj)
#pragma unroll
                    for (int n = 0; n < 2; ++n) *(f32x4*)(rowp + bj * HALF + n * 16) = acc[ai][bj][m][n]; }
    }
};

}
namespace att {
#define ATT_LAS __attribute__((address_space(3)))
typedef unsigned short bf16;
using bf16x8 = __attribute__((ext_vector_type(8))) short;
using s16x4  = __attribute__((ext_vector_type(4))) short;
using f32x16 = __attribute__((ext_vector_type(16))) float;
using u32x4  = __attribute__((ext_vector_type(4))) unsigned;
constexpr int NW = 8, QBLK = 32, KVBLK = 64, DV = 128;
constexpr float THR = 8.f;
#define ATT_SBAR() __builtin_amdgcn_sched_barrier(0)
__device__ __forceinline__ int crow(int r, int hi) { return (r & 3) + 8 * (r >> 2) + 4 * hi; }
__device__ __forceinline__ unsigned cvtpk(float lo, float hi) { unsigned r; asm volatile("v_cvt_pk_bf16_f32 %0, %1, %2" : "=v"(r) : "v"(lo), "v"(hi)); return r; }
typedef unsigned rawx4 __attribute__((ext_vector_type(4)));
__device__ __forceinline__ __amdgpu_buffer_rsrc_t mk_rsrc(const void* p) {
  const unsigned long long a = (unsigned long long)p; const unsigned lo = __builtin_amdgcn_readfirstlane((unsigned)a), hi = __builtin_amdgcn_readfirstlane((unsigned)(a >> 32));
  return __builtin_amdgcn_make_buffer_rsrc((void*)(((unsigned long long)hi << 32) | lo), 0, 0x7ffffffc, 0x00020000);
}
__device__ __forceinline__ bf16x8 ld16(__amdgpu_buffer_rsrc_t r, int voff, int soff) { const rawx4 v = __builtin_amdgcn_raw_buffer_load_b128(r, voff, soff, 0); return *reinterpret_cast<const bf16x8*>(&v); }
template <int DK> __device__ __forceinline__ int kswz(int row) { return DK == 192 ? ((row >> 1) & 7) : (row & 7); }
template <int DK> struct Cfg { static constexpr float SCALE = DK == 128 ? 0.088388347648318440f : 0.072168783648703220f;
    static constexpr int SHM_V = KVBLK * DV * 2, SHM_K = KVBLK * DK * 2, SHM_WS = 2 * SHM_V + 2 * SHM_K, SHM_RPB = SHM_WS + NW * 64 * 4, SHM_QR = SHM_RPB + 2048, SHM_END = SHM_QR;
    static constexpr int NQR = DK / 16;
    static constexpr int NKP = DK / 64;     static constexpr int SDEPTH = DK == 128 ? 2 : 1; };

template <int DK> __device__ __forceinline__ void partialSM(f32x16& p0, f32x16& p1, float& m_reg, float& mn, float& alpha) {
  constexpr float SCALE = Cfg<DK>::SCALE, C = SCALE * 1.4426950408889634f;
  float pmax = p0[0];
#pragma unroll
  for (int r = 1; r < 16; ++r) pmax = fmaxf(pmax, p0[r]);
#pragma unroll
  for (int r = 0; r < 16; ++r) pmax = fmaxf(pmax, p1[r]);
  { auto rr = __builtin_amdgcn_permlane32_swap(__float_as_uint(pmax), __float_as_uint(pmax), false, false);
    pmax = fmaxf(__uint_as_float(rr[0]), __uint_as_float(rr[1])); }
  if (__builtin_expect(__all(pmax - m_reg <= THR / SCALE), 1)) { mn = m_reg; alpha = 1.f; }
  else { mn = fmaxf(m_reg, pmax); alpha = __builtin_amdgcn_exp2f((m_reg - mn) * C); m_reg = mn; }
  const float mnC = -mn * C;
#pragma unroll
  for (int r = 0; r < 16; ++r) p0[r] = fmaf(p0[r], C, mnC);
#pragma unroll
  for (int r = 0; r < 16; ++r) p1[r] = fmaf(p1[r], C, mnC);
#pragma unroll
  for (int r = 0; r < 16; ++r) p0[r] = __builtin_amdgcn_exp2f(p0[r]);
}
__device__ __forceinline__ void finishSM(f32x16& p0, f32x16& p1, float alpha, float& l_reg, bf16x8& pa0, bf16x8& pa1, bf16x8& pa2, bf16x8& pa3) {
#pragma unroll
  for (int r = 0; r < 16; ++r) p1[r] = __builtin_amdgcn_exp2f(p1[r]);
  float ps = 0;
#pragma unroll
  for (int r = 0; r < 16; ++r) ps += p0[r];
#pragma unroll
  for (int r = 0; r < 16; ++r) ps += p1[r];
  { auto rr = __builtin_amdgcn_permlane32_swap(__float_as_uint(ps), __float_as_uint(ps), false, false);
    ps = __uint_as_float(rr[0]) + __uint_as_float(rr[1]); }
  l_reg = l_reg * alpha + ps;
#define ATT_PK4(P, BASE, OUT) do { unsigned a0 = cvtpk(P[BASE + 0], P[BASE + 1]), a1 = cvtpk(P[BASE + 2], P[BASE + 3]);   \
    unsigned b0 = cvtpk(P[BASE + 4], P[BASE + 5]), b1 = cvtpk(P[BASE + 6], P[BASE + 7]);                              \
    auto r0 = __builtin_amdgcn_permlane32_swap(a0, b0, false, false); auto r1 = __builtin_amdgcn_permlane32_swap(a1, b1, false, false); \
    u32x4 w = {r0[0], r1[0], r0[1], r1[1]}; OUT = *reinterpret_cast<bf16x8*>(&w); } while (0)
  ATT_PK4(p0, 0, pa0); ATT_PK4(p0, 8, pa1); ATT_PK4(p1, 0, pa2); ATT_PK4(p1, 8, pa3);
#undef ATT_PK4
}
struct NaWave { int na;
                int r0w;
                int rq;
                int cq, c0;
                int rlo;
                const ATT_LAS float* rpb; };
#define ATT_KRD(dst, d0, half) asm volatile("ds_read_b128 %0, %1 offset:%2" : "=v"(dst) : "v"(ksb + kx[(d0) & 3]), "n"(((d0) >> 2) * 128 + (half) * 32 * (DK * 2)) : "memory")
template <int DK> __device__ __forceinline__ void qkt_pre(bf16x8& fa, bf16x8& fb, int ksb, const int (&kx)[4]) { ATT_KRD(fa, 0, 0); ATT_KRD(fb, 0, 1); }
template <int DK, bool NA> __device__ __forceinline__ void qkt(f32x16& p0, f32x16& p1, bf16x8 fa, bf16x8 fb, int ksb, const bf16x8* qr, const char* qlds, const int (&kx)[4], int hi, const NaWave& nw, int tile) {
  p0 = f32x16{}; p1 = f32x16{};
  if constexpr (NA) {
    if (nw.na && tile >= 4) {
      const int kr = nw.rlo + (tile - 4);
      if (kr >= nw.r0w && kr < nw.r0w + 8) {
        const int base = (kr - nw.rq + 7) * 31 - nw.cq + 15;
#pragma unroll
        for (int r = 0; r < 16; ++r) { const int ck = crow(r, hi); const bool ok0 = (unsigned)(ck - nw.c0) < 16u, ok1 = (unsigned)(ck + 32 - nw.c0) < 16u;
          const float b0 = nw.rpb[ok0 ? base + ck : 0], b1 = nw.rpb[ok1 ? base + ck + 32 : 0];
          p0[r] = ok0 ? b0 : -1e30f; p1[r] = ok1 ? b1 : -1e30f; }
      } else {
#pragma unroll
        for (int r = 0; r < 16; ++r) { p0[r] = -1e30f; p1[r] = -1e30f; }
      }
    }
  }
  constexpr int ND = DK / 16;
  bf16x8 f[3][2]; f[0][0] = fa; f[0][1] = fb;
  ATT_KRD(f[1][0], 1, 0); ATT_KRD(f[1][1], 1, 1);
#pragma unroll
  for (int d0 = 0; d0 < ND; ++d0) {
    if (d0 + 2 < ND) { ATT_KRD(f[(d0 + 2) % 3][0], d0 + 2, 0); ATT_KRD(f[(d0 + 2) % 3][1], d0 + 2, 1); }
    asm volatile("s_waitcnt lgkmcnt(%2)" : "+v"(f[d0 % 3][0]), "+v"(f[d0 % 3][1]) : "n"(d0 + 2 < ND ? 4 : (d0 + 1 < ND ? 2 : 0)) : "memory");
    bf16x8 qf; if (d0 < Cfg<DK>::NQR) qf = qr[d0 < Cfg<DK>::NQR ? d0 : 0]; else qf = *reinterpret_cast<const bf16x8*>(qlds + (d0 - Cfg<DK>::NQR) * 1024);
    p0 = __builtin_amdgcn_mfma_f32_32x32x16_bf16(f[d0 % 3][0], qf, p0, 0, 0, 0);
    p1 = __builtin_amdgcn_mfma_f32_32x32x16_bf16(f[d0 % 3][1], qf, p1, 0, 0, 0); }
}
#undef ATT_KRD
__device__ __forceinline__ int v_st(int k, int c) { const int kk = (k & ~0xC) | ((k & 4) << 1) | ((k & 8) >> 1); return ((kk >> 3) * 4 + (c >> 5)) * 512 + ((kk & 7) * 32 + (c & 31)) * 2; }
__device__ __forceinline__ int v_rd_base(int lane) { return ((lane & 3) << 3) | (((lane >> 2) & 3) << 6) | (((lane >> 4) & 1) << 5) | (((lane >> 5) & 1) << 8); }
constexpr int v_rd_off(int d0, int ks, int half) { return d0 * 512 + ks * 4096 + half * 2048; }
template <int OFF> __device__ __forceinline__ s16x4 tr_read(int vb) {
  s16x4 r; asm volatile("ds_read_b64_tr_b16 %0, %1 offset:%2" : "=&v"(r) : "v"(vb), "i"(OFF) : "memory"); return r;
}
struct VHalf { s16x4 la, ha, lb, hb; };
template <int HB> __device__ __forceinline__ void pv_read(VHalf& f, int vb) {
  constexpr int D0 = HB >> 1, K0 = 2 * (HB & 1);
  f.la = tr_read<v_rd_off(D0, K0, 0)>(vb); f.ha = tr_read<v_rd_off(D0, K0, 1)>(vb); f.lb = tr_read<v_rd_off(D0, K0 + 1, 0)>(vb); f.hb = tr_read<v_rd_off(D0, K0 + 1, 1)>(vb);
}
__device__ __forceinline__ void pv_mma(f32x16& od, const VHalf& f, bf16x8 pa, bf16x8 pb) {
#define ATT_PK(L, H) (bf16x8){L[0], L[1], L[2], L[3], H[0], H[1], H[2], H[3]}
  od = __builtin_amdgcn_mfma_f32_32x32x16_bf16(pa, ATT_PK(f.la, f.ha), od, 0, 0, 0);
  od = __builtin_amdgcn_mfma_f32_32x32x16_bf16(pb, ATT_PK(f.lb, f.hb), od, 0, 0, 0);
#undef ATT_PK
}
__device__ __forceinline__ void pv_d0(f32x16* o, int vb, bf16x8 pa0, bf16x8 pa1, bf16x8 pa2, bf16x8 pa3) {
  VHalf f0, f1, f2;
#define ATT_PVW(n) do { asm volatile("s_waitcnt lgkmcnt(" #n ")" ::: "memory"); ATT_SBAR(); } while (0)
  pv_read<0>(f0, vb); pv_read<1>(f1, vb);
  pv_read<2>(f2, vb); ATT_PVW(8); pv_mma(o[0], f0, pa0, pa1); ATT_SBAR();
  pv_read<3>(f0, vb); ATT_PVW(8); pv_mma(o[0], f1, pa2, pa3); ATT_SBAR();
  pv_read<4>(f1, vb); ATT_PVW(8); pv_mma(o[1], f2, pa0, pa1); ATT_SBAR();
  pv_read<5>(f2, vb); ATT_PVW(8); pv_mma(o[1], f0, pa2, pa3); ATT_SBAR();
  pv_read<6>(f0, vb); ATT_PVW(8); pv_mma(o[2], f1, pa0, pa1); ATT_SBAR();
  pv_read<7>(f1, vb); ATT_PVW(8); pv_mma(o[2], f2, pa2, pa3); ATT_SBAR();
  ATT_PVW(4); pv_mma(o[3], f0, pa0, pa1); ATT_SBAR();
  ATT_PVW(0); pv_mma(o[3], f1, pa2, pa3);
#undef ATT_PVW
}

template <int DK, bool NA, class Side>
__device__ __forceinline__ void attn_body(const bf16* __restrict__ Qb, int ldq, const bf16* __restrict__ Kh, int ldk, const bf16* __restrict__ Vh, int ldv,
                                          bf16* __restrict__ Ob, int ldo, int NT, int seg2, int vr_ctx, int vr_lat, const NaWave& nw, char* lds, Side& sd) {
  using C_ = Cfg<DK>; constexpr int SHM_V = C_::SHM_V, SHM_K = C_::SHM_K, NKP = C_::NKP;
  int tid = threadIdx.x; asm volatile("" : "+v"(tid));
  const int wid = tid >> 6, lane = tid & 63, r32 = lane & 31, hi = lane >> 5;
  char* V_lds = lds; char* K_lds = lds + 2 * SHM_V;
  float* wsf = (float*)(lds + C_::SHM_WS) + wid * 64; float* li_l = wsf; float* al_l = wsf + 32;
  float m_reg = -1e30f, l_reg = 0; f32x16 o[4] = {}; bf16x8 qr[C_::NQR]; char* qlds = nullptr;
  __syncthreads();
  const bf16* Qw = Qb + (long)(wid * QBLK + r32) * ldq + hi * 8;
#pragma unroll
  for (int d0 = 0; d0 < DK / 16; ++d0) { const bf16x8 qv = *reinterpret_cast<const bf16x8*>(Qw + d0 * 16); if (d0 < C_::NQR) qr[d0 < C_::NQR ? d0 : 0] = qv; else *reinterpret_cast<bf16x8*>(qlds + (d0 - C_::NQR) * 1024) = qv; }
  const int sr = tid >> 4, sc = (tid & 15) * 8, vst0 = v_st(sr, sc), vst1 = vst0 + 8192;
  const __amdgpu_buffer_rsrc_t krs = mk_rsrc(Kh), vrs = mk_rsrc(Vh); const int vgo0 = (sr * ldv + sc) * 2, ldk2 = __builtin_amdgcn_readfirstlane(ldk * 2), ldv2 = __builtin_amdgcn_readfirstlane(ldv * 2);
  const int kgo0 = ((tid >> 3) * ldk + (tid & 7) * 8) * 2, klo0 = (tid >> 3) * (DK * 2) + (((tid & 7) * 16) ^ (kswz<DK>(tid >> 3) << 4));
  const int vb0 = (int)(uintptr_t)V_lds + v_rd_base(lane);
  int kx[4];
#pragma unroll
  for (int dl = 0; dl < 4; ++dl) kx[dl] = r32 * (DK * 2) + ((dl * 32 + hi * 16) ^ (kswz<DK>(r32) << 4));
  bf16x8 vs0, vs1, ks[NKP];
#define ATT_KOFF(t) ((t) * KVBLK + ((NA && (t) >= 4) ? seg2 : 0))
#define ATT_VOFF(t) (((t) < 4 ? vr_ctx : vr_lat) + (t) * KVBLK + ((NA && (t) >= 4) ? seg2 : 0))
#define ATT_SLOAD(t) do { const int k0_ = __builtin_amdgcn_readfirstlane(ATT_KOFF(t)); vs0 = ld16(vrs, vgo0, k0_ * ldv2); vs1 = ld16(vrs, vgo0, (k0_ + 32) * ldv2); \
    _Pragma("unroll") for (int q_ = 0; q_ < NKP; ++q_) ks[q_] = ld16(krs, kgo0 + 128 * q_, k0_ * ldk2); } while (0)
#define ATT_SWRITE(b) do { *(bf16x8*)(V_lds + (b) * SHM_V + vst0) = vs0; *(bf16x8*)(V_lds + (b) * SHM_V + vst1) = vs1; \
    _Pragma("unroll") for (int q_ = 0; q_ < NKP; ++q_) *(bf16x8*)(K_lds + (b) * SHM_K + klo0 + 128 * q_) = ks[q_]; } while (0)
  const int vla = (int)(uintptr_t)V_lds + vst0, kla = (int)(uintptr_t)K_lds + klo0;
  typedef unsigned srd_t __attribute__((ext_vector_type(4)));
  srd_t ksrd, vsrd;
  { const unsigned long long ka_ = (unsigned long long)Kh, va_ = (unsigned long long)Vh;
    ksrd = (srd_t){(unsigned)__builtin_amdgcn_readfirstlane((unsigned)ka_), (unsigned)__builtin_amdgcn_readfirstlane((unsigned)(ka_ >> 32)), 0x7ffffffcu, 0x00020000u};
    vsrd = (srd_t){(unsigned)__builtin_amdgcn_readfirstlane((unsigned)va_), (unsigned)__builtin_amdgcn_readfirstlane((unsigned)(va_ >> 32)), 0x7ffffffcu, 0x00020000u}; }
#define ATT_BLD(dst, srd, voff, soff, imm) asm volatile("buffer_load_dwordx4 %0, %1, %2, %3 offen offset:%4" : "=v"(dst) : "v"(voff), "s"(srd), "s"(soff), "n"(imm) : "memory")
#define ATT_SLOAD_ASM(t) do { const int k0_ = __builtin_amdgcn_readfirstlane(ATT_KOFF(t)); const int sv0_ = __builtin_amdgcn_readfirstlane(k0_ * ldv2), sv1_ = __builtin_amdgcn_readfirstlane((k0_ + 32) * ldv2), sk_ = __builtin_amdgcn_readfirstlane(k0_ * ldk2); \
    ATT_BLD(vs0, vsrd, vgo0, sv0_, 0); ATT_BLD(vs1, vsrd, vgo0, sv1_, 0); _Pragma("unroll") for (int q_ = 0; q_ < NKP; ++q_) ATT_BLD(ks[q_], ksrd, kgo0, sk_, 128 * q_); } while (0)
#define ATT_DSW(addr, off, val) asm volatile("ds_write_b128 %0, %1 offset:%2" :: "v"(addr), "v"(val), "n"(off) : "memory")
#define ATT_SWRITE_ASM(b) do { const int va_ = vla + (b) * SHM_V, ka_ = kla + (b) * SHM_K; ATT_DSW(va_, 0, vs0); ATT_DSW(va_, 8192, vs1); \
    _Pragma("unroll") for (int q_ = 0; q_ < NKP; ++q_) ATT_DSW(ka_, 128 * q_, ks[q_]); } while (0)
#define ATT_VLOAD_ASM(t) do { const int k0_ = __builtin_amdgcn_readfirstlane(ATT_VOFF(t)); const int sv0_ = __builtin_amdgcn_readfirstlane(k0_ * ldv2), sv1_ = __builtin_amdgcn_readfirstlane((k0_ + 32) * ldv2); \
    ATT_BLD(vs0, vsrd, vgo0, sv0_, 0); ATT_BLD(vs1, vsrd, vgo0, sv1_, 0); } while (0)
#define ATT_KLOAD_ASM(t) do { const int k0_ = __builtin_amdgcn_readfirstlane(ATT_KOFF(t)); const int sk_ = __builtin_amdgcn_readfirstlane(k0_ * ldk2); \
    _Pragma("unroll") for (int q_ = 0; q_ < NKP; ++q_) ATT_BLD(ks[q_], ksrd, kgo0, sk_, 128 * q_); } while (0)
#define ATT_VWRITE_ASM(b) do { const int va_ = vla + (b) * SHM_V; ATT_DSW(va_, 0, vs0); ATT_DSW(va_, 8192, vs1); } while (0)
#define ATT_KWRITE_ASM(b) do { const int ka_ = kla + (b) * SHM_K; _Pragma("unroll") for (int q_ = 0; q_ < NKP; ++q_) ATT_DSW(ka_, 128 * q_, ks[q_]); } while (0)
#pragma unroll
  for (int q_ = 0; q_ < NKP; ++q_) ks[q_] = ld16(krs, kgo0 + 128 * q_, 0);
  asm volatile("s_waitcnt vmcnt(0)" ::: "memory");
#pragma unroll
  for (int q_ = 0; q_ < NKP; ++q_) *(bf16x8*)(K_lds + klo0 + 128 * q_) = ks[q_];
  __syncthreads();
#pragma unroll
  for (int d0 = 0; d0 < C_::NQR; ++d0) asm volatile("" :: "v"(qr[d0]));
  const int grp = __builtin_amdgcn_readfirstlane(wid >> 2);
  f32x16 p0 = {}, p1 = {}; bf16x8 pa0 = {}, pa1 = {}, pa2 = {}, pa3 = {}; float alpha_c = 1.f; int sflag = 0;
  vs0 = bf16x8{}; vs1 = bf16x8{};
#define ATT_EVEN_HEAD(te, issuer) do { sflag = 0; if ((te) < NT) { ATT_VLOAD_ASM(te); if ((te) + 1 < NT) ATT_KLOAD_ASM((te) + 1); if (sd.step_load(tid, issuer) && (issuer)) sflag = 1; } } while (0)
#define ATT_WAIT_ASM(NY, ...) asm volatile("s_cmp_eq_u32 %[flag], 0\n\ts_cbranch_scc1 .Latt_w0_%=\n\ts_waitcnt vmcnt(" #NY ")\n\ts_branch .Latt_w1_%=\n.Latt_w0_%=:\n\ts_waitcnt vmcnt(0)\n.Latt_w1_%=:" : __VA_ARGS__ : [flag] "s"(s2_) : "memory", "scc")
#define ATT_ODD_TAIL(te, NY) do { if ((te) < NT) { const int s2_ = __builtin_amdgcn_readfirstlane(sflag); \
      if constexpr (NKP == 2) ATT_WAIT_ASM(NY, "+v"(vs0), "+v"(vs1), "+v"(ks[0]), "+v"(ks[1])); else ATT_WAIT_ASM(NY, "+v"(vs0), "+v"(vs1), "+v"(ks[0]), "+v"(ks[1]), "+v"(ks[NKP - 1])); \
      ATT_VWRITE_ASM((te) & 1); if ((te) + 1 < NT) ATT_KWRITE_ASM(((te) + 1) & 1); } } while (0)
#define ATT_HBAR() do { ATT_SBAR(); asm volatile("s_waitcnt lgkmcnt(0)" ::: "memory"); __builtin_amdgcn_s_barrier(); asm volatile("" ::: "memory"); ATT_SBAR(); } while (0)
#define ATT_MSEG(t) do { __builtin_amdgcn_s_setprio(1); bf16x8 kfa_ = {}, kfb_ = {}; const int ksb_ = (int)(uintptr_t)K_lds + ((t) & 1) * SHM_K; if ((t) < NT) qkt_pre<DK>(kfa_, kfb_, ksb_, kx); \
      if ((t) >= 1) { if (__any(alpha_c < 1.f)) { if (hi == 0) al_l[r32] = alpha_c; asm volatile("s_waitcnt lgkmcnt(0)" ::: "memory"); \
          _Pragma("unroll") for (int d = 0; d < 4; ++d) _Pragma("unroll") for (int r = 0; r < 16; ++r) o[d][r] *= al_l[crow(r, hi)]; } \
        ATT_SBAR(); pv_d0(o, vb0 + (((t) - 1) & 1) * SHM_V, pa0, pa1, pa2, pa3); } \
      if ((t) < NT) qkt<DK, NA>(p0, p1, kfa_, kfb_, ksb_, qr, qlds, kx, hi, nw, (t)); \
      __builtin_amdgcn_s_setprio(0); } while (0)
#define ATT_SSEG() do { float mn_, alpha_; partialSM<DK>(p0, p1, m_reg, mn_, alpha_); finishSM(p0, p1, alpha_, l_reg, pa0, pa1, pa2, pa3); alpha_c = alpha_; } while (0)
  if (grp == 0) {
    ATT_EVEN_HEAD(0, false);
    for (int te = 0; te <= NT; ++te) {
      ATT_MSEG(te); ATT_HBAR();
      if (te < NT) ATT_SSEG();
      if (sd.step_emit(tid, true)) sflag = 1;
      ATT_ODD_TAIL(te, 2);
      ATT_EVEN_HEAD(te + 1, false);
      ATT_HBAR();
    }
  } else {
    for (int te = 0; te <= NT; ++te) {
      ATT_EVEN_HEAD(te, true); if (te >= 1) ATT_SSEG();
      ATT_HBAR();
      ATT_MSEG(te); sd.step_emit(tid, false); ATT_ODD_TAIL(te, 4); ATT_HBAR();
    }
  }
#undef ATT_EVEN_HEAD
#undef ATT_WAIT_ASM
#undef ATT_ODD_TAIL
#undef ATT_HBAR
#undef ATT_MSEG
#undef ATT_SSEG
#undef ATT_VLOAD_ASM
#undef ATT_KLOAD_ASM
#undef ATT_VWRITE_ASM
#undef ATT_KWRITE_ASM
  if (hi == 0) li_l[r32] = l_reg; asm volatile("s_waitcnt lgkmcnt(0)" ::: "memory");
  float rli[16];
#pragma unroll
  for (int r = 0; r < 16; ++r) rli[r] = __builtin_amdgcn_rcpf(li_l[crow(r, hi)]);
  bf16* Ow = Ob + (long)(wid * QBLK) * ldo;
#pragma unroll
  for (int r = 0; r < 16; ++r) { const int orow = crow(r, hi);
#pragma unroll
    for (int d0 = 0; d0 < 4; ++d0) Ow[(long)orow * ldo + d0 * 32 + r32] = (bf16)(cvtpk(o[d0][r] * rli[r], 0.f) & 0xffffu); }
#undef ATT_KOFF
#undef ATT_VOFF
#undef ATT_SLOAD
#undef ATT_SWRITE
#undef ATT_SWRITE_ASM
#undef ATT_SLOAD_ASM
#undef ATT_BLD
#undef ATT_DSW
}

}
#define GAS __attribute__((address_space(1)))
#define LAS __attribute__((address_space(3)))
typedef unsigned short bf16;
typedef unsigned v4u __attribute__((ext_vector_type(4)));
typedef unsigned v2u __attribute__((ext_vector_type(2)));
typedef float f32x4 __attribute__((ext_vector_type(4)));
typedef short bf16x8 __attribute__((ext_vector_type(8)));
constexpr int NWAVES = 8;
constexpr int DM = 4096, SEQ = 4096, CTXL = 256, DFF = 10240, NLAT = 8192, NCTXR = 512, MROWS = 8704, NKEY = 4352, NMOD = 9;
constexpr int EVN = 9216, DLN = 1792, UQN = 6144, UKVN = 8192;
constexpr float EPS = 1e-6f;
constexpr size_t MiB = 1u << 20;
constexpr size_t WS_CTL = 0, CTL_ZERO_BYTES = 1 * MiB;
constexpr size_t WS_MOD = 1 * MiB;
constexpr size_t WS_WT1 = 2 * MiB, WT1_SZ = 160 * MiB;
constexpr size_t WS_WT2 = 642 * MiB, WT2_SZ = 80 * MiB;
constexpr size_t WS_WIN = 962 * MiB, WS_WOUT = 1034 * MiB, WS_WDOWN = 1066 * MiB, WS_WUQ = 1080 * MiB, WS_WUKV = 1092 * MiB, WS_WO = 1100 * MiB;
constexpr size_t WS_HA = 1132 * MiB, WS_HB = 1268 * MiB;
constexpr size_t WS_U = 1404 * MiB;
constexpr size_t WS_HID = 1472 * MiB;
constexpr size_t WS_AO = 1642 * MiB;
constexpr size_t WS_P = 1710 * MiB;
constexpr size_t WS_QB = 1863 * MiB;
constexpr size_t WS_KN = 1931 * MiB, WS_VN = 1965 * MiB;
constexpr size_t WS_KG = 1999 * MiB, WS_VG = 2008 * MiB;
constexpr size_t WS_DL = 2017 * MiB;
constexpr size_t WS_CQN = 2077 * MiB, WS_CKVN = 2094 * MiB, WS_KR = 2103 * MiB;
constexpr size_t WS_QRAW = 2105 * MiB, WS_KVRAW = 2201 * MiB;
constexpr size_t WS_QM = 2337 * MiB, WS_KM = 2433 * MiB, WS_VM = 2535 * MiB;
constexpr size_t WS_SLAB = 2603 * MiB;
constexpr size_t WS_DBG = 2667 * MiB;
constexpr size_t WS_END = 2668 * MiB;
constexpr int CW_BAR = 4096;
constexpr int RING_BYTES = 131072, LDS_BYTES = 147456, LDSCTL_OFF = LDS_BYTES - 1024, MISC_OFF = LDSCTL_OFF + 320;

#define LDS_WAIT() asm volatile("s_waitcnt lgkmcnt(0)" ::: "memory")
#define VM_WAIT() asm volatile("s_waitcnt vmcnt(0)" ::: "memory")
__device__ __forceinline__ unsigned f2bf(float f) { unsigned u = __builtin_bit_cast(unsigned, f); return (u + 0x7fffu + ((u >> 16) & 1u)) >> 16; }
__device__ __forceinline__ unsigned pk2(float lo, float hi) { return f2bf(lo) | (f2bf(hi) << 16); }
__device__ __forceinline__ float bf2f(unsigned short b) { return __builtin_bit_cast(float, ((unsigned)b) << 16); }
__device__ __forceinline__ float bflo(unsigned w) { return __builtin_bit_cast(float, w << 16); }
__device__ __forceinline__ float bfhi(unsigned w) { return __builtin_bit_cast(float, w & 0xffff0000u); }

#define XB_TMO      128
#define XB_XCNT(j)  (256  + 64 * (j))
#define XB_XSUB(j)  (1280 + 64 * (j))
#define XB_XGEN(j)  (2304 + 64 * (j))
#define XB_TOP      3328
#define XB_TOPGEN   3392
#define XCD_BAR_WORDS 3456
#define XB_SPIN_CAP (1u << 22)
__device__ __forceinline__ unsigned xb_ld(unsigned* p)              { return __hip_atomic_load(p, __ATOMIC_RELAXED, __HIP_MEMORY_SCOPE_AGENT); }
__device__ __forceinline__ unsigned xb_add(unsigned* p, unsigned v) { return __hip_atomic_fetch_add(p, v, __ATOMIC_RELAXED, __HIP_MEMORY_SCOPE_AGENT); }
__device__ __forceinline__ unsigned xb_xcc_id() { return (unsigned)__builtin_amdgcn_s_getreg((3 << 11) | 20) & 0xFu; }
#define XB_SPIN(cond, bar) do { unsigned _sp = 0; while (cond) { __builtin_amdgcn_s_sleep(1); \
    if ((++_sp & 255u) == 0u) { if (xb_ld(&(bar)[XB_TMO])) break; if (_sp > XB_SPIN_CAP) { atomicAdd(&(bar)[XB_TMO], 1u); break; } } } } while (0)
struct XcdBarrier { unsigned* bar; unsigned x; volatile LAS unsigned* st; };
__device__ __forceinline__ XcdBarrier xcd_barrier_post(unsigned* bar, volatile LAS unsigned* st) {
    XcdBarrier b; b.bar = bar; b.x = xb_xcc_id(); b.st = st;
    if (threadIdx.x == 0) (void)xb_add(&bar[XB_XCNT(b.x)], 1u);
    return b;
}
__device__ __forceinline__ void xcd_barrier_complete(unsigned* bar, unsigned x, unsigned& nloc, unsigned& nx) {
    const unsigned G = gridDim.x * gridDim.y * gridDim.z;
    unsigned sum, cnt, mine, sp = 0u;
    for (;;) {
        sum = 0u; cnt = 0u; mine = 0u;
#pragma unroll
        for (unsigned j = 0; j < 16; ++j) { const unsigned c = xb_ld(&bar[XB_XCNT(j)]); sum += c; cnt += (c > 0u) ? 1u : 0u; mine = (j == x) ? c : mine; }
        if (sum == G) break;
        __builtin_amdgcn_s_sleep(1);
        if ((++sp & 255u) == 0u) { if (xb_ld(&bar[XB_TMO])) break; if (sp > XB_SPIN_CAP) { atomicAdd(&bar[XB_TMO], 1u); break; } }
    }
    nloc = mine > 0u ? mine : 1u; nx = cnt > 0u ? cnt : 1u;
}
__device__ __forceinline__ void xcd_barrier(const XcdBarrier& b) {
    asm volatile("s_waitcnt vmcnt(0)" ::: "memory");
    __syncthreads();
    if (threadIdx.x == 0) {
        unsigned* bar = b.bar;
        __builtin_amdgcn_s_waitcnt(0);
        unsigned nloc = b.st[0], nx = b.st[1];
        if (nloc == 0u) { xcd_barrier_complete(bar, b.x, nloc, nx); b.st[0] = nloc; b.st[1] = nx; }
        const unsigned old = xb_add(&bar[XB_XSUB(b.x)], 1u);
        const unsigned gen = old / nloc;
        if (old + 1u == (gen + 1u) * nloc) {
            __builtin_amdgcn_fence(__ATOMIC_RELEASE, "agent");
            asm volatile("s_waitcnt vmcnt(0)" ::: "memory");
            const unsigned og = xb_add(&bar[XB_TOP], 1u);
            const unsigned tg = og / nx;
            if (og + 1u == (tg + 1u) * nx) xb_add(&bar[XB_TOPGEN], 1u);
            else XB_SPIN(xb_ld(&bar[XB_TOPGEN]) == tg, bar);
            __builtin_amdgcn_fence(__ATOMIC_ACQUIRE, "agent");
            xb_add(&bar[XB_XGEN(b.x)], 1u);
            asm volatile("s_waitcnt vmcnt(0)" ::: "memory");
        } else {
            XB_SPIN(xb_ld(&bar[XB_XGEN(b.x)]) == gen, bar);
            __builtin_amdgcn_fence(__ATOMIC_ACQUIRE, "agent");
            asm volatile("s_waitcnt vmcnt(0)" ::: "memory");
        }
    }
    __syncthreads();
}

struct Args { const float* in[26]; float* out; unsigned char* ws; int ph_lo, ph_hi, chk, pad; };
struct Ctx {
    LAS unsigned char* lds; int tid, lane, wave, vcu, G;
    const float* const* in; float* out; unsigned char* ws;
};
__device__ __forceinline__ float wave_sum(float v) {
#pragma unroll
    for (int o = 1; o < 64; o <<= 1) v += __shfl_xor(v, o);
    return v;
}
#ifndef CV_NT
#define CV_NT 1
#endif
__device__ __forceinline__ void p0_transpose_item(const float* W, int K, int N, bf16* WT, int drow0, LAS float* scr, int k0, int n0, int lane) {
    const int c4 = (lane & 15) * 4, kq = lane >> 4;
    f32x4 v[16];
#pragma unroll
    for (int i = 0; i < 16; ++i) v[i] = CV_NT ? __builtin_nontemporal_load((const f32x4*)(W + (size_t)(k0 + 4 * i + kq) * N + n0 + c4)) : *(const f32x4*)(W + (size_t)(k0 + 4 * i + kq) * N + n0 + c4);
#pragma unroll
    for (int i = 0; i < 16; ++i) { LAS float* d = scr + (4 * i + kq) * 65 + c4; d[0] = v[i].x; d[1] = v[i].y; d[2] = v[i].z; d[3] = v[i].w; }
    LDS_WAIT(); asm volatile("" ::: "memory");
    const int c = lane & 7;
#pragma unroll
    for (int j = 0; j < 8; ++j) { const int n = (lane >> 3) + 8 * j; const LAS float* s = scr + (8 * c) * 65 + n;
        v4u o; o.x = pk2(s[0 * 65], s[1 * 65]); o.y = pk2(s[2 * 65], s[3 * 65]); o.z = pk2(s[4 * 65], s[5 * 65]); o.w = pk2(s[6 * 65], s[7 * 65]);
        const int dr = drow0 + n;
        GAS v4u* dp = (GAS v4u*)(WT + (((size_t)(dr >> 8) * (K >> 6) + (k0 >> 6)) * 256 + (dr & 255)) * 64 + 8 * c);
        if (CV_NT) __builtin_nontemporal_store(o, dp); else *dp = o; }
    LDS_WAIT(); asm volatile("" ::: "memory");
}
constexpr int CV_W1_ITEMS = (DM / 64) * (2 * DFF / 64), CV_W2_ITEMS = (DFF / 64) * (DM / 64), CV_WIN_ITEMS = (DM / 64) * (EVN / 64), CV_SQ_ITEMS = (DM / 64) * (DM / 64),
              CV_DOWN_ITEMS = (DM / 64) * (1600 / 64), CV_UQ_ITEMS = (1024 / 64) * (UQN / 64), CV_UKV_ITEMS = (512 / 64) * (UKVN / 64);
constexpr int CV_E0 = CV_W1_ITEMS, CV_E1 = CV_E0 + CV_W2_ITEMS, CV_E2 = CV_E1 + CV_WIN_ITEMS, CV_E3 = CV_E2 + CV_SQ_ITEMS, CV_E4 = CV_E3 + CV_W1_ITEMS, CV_E5 = CV_E4 + CV_W2_ITEMS,
              CV_E6 = CV_E5 + CV_W1_ITEMS, CV_E7 = CV_E6 + CV_W2_ITEMS, CV_E8 = CV_E7 + CV_DOWN_ITEMS, CV_E9 = CV_E8 + CV_UQ_ITEMS, CV_E10 = CV_E9 + CV_UKV_ITEMS, CV_E11 = CV_E10 + CV_SQ_ITEMS,
              CV_E12 = CV_E11 + CV_W1_ITEMS, CV_TOTAL = CV_E12 + CV_W2_ITEMS;
#ifndef CV_T2
#define CV_T2 18000
#define CV_T5 10000
#define CV_A7 27296
#define CV_T10 18000
#define CV_T13 18000
#define CV_T16 3000
#define CV_T18 4000
#define CV_A20 24216
#endif
constexpr int CV_P0 = CV_TOTAL - (CV_T2 + CV_T5 + CV_A7 + CV_T10 + CV_T13 + CV_T16 + CV_T18 + CV_A20);
constexpr int CV_S2 = CV_P0, CV_S5 = CV_S2 + CV_T2, CV_S7 = CV_S5 + CV_T5, CV_S10 = CV_S7 + CV_A7, CV_S13 = CV_S10 + CV_T10, CV_S16 = CV_S13 + CV_T13, CV_S18 = CV_S16 + CV_T16, CV_S20 = CV_S18 + CV_T18;
static_assert(CV_S20 + CV_A20 == CV_TOTAL && CV_P0 >= CV_E0, "conversion schedule: P0 must at least cover the first SwiGLU weight");
static_assert(CV_S5 >= CV_E2, "W2[l0,f0] and W_in are converted by the end of phase 2's tail");
static_assert(CV_S10 >= CV_E4, "W_out and W1[l0,f1] are converted by the end of phase 7");
static_assert(CV_S13 >= CV_E6, "W2[l0,f1] and W1[l1,f0] are converted by the end of phase 10's tail");
static_assert(CV_S16 >= CV_E8, "W2[l1,f0] and W_down are converted by the end of phase 13's tail");
static_assert(CV_S18 >= CV_E10, "W_uq and W_ukv are converted by the end of phase 16's tail");
static_assert(CV_A7 <= 156 * 256 && CV_A20 <= 268 * 256, "attention side stream: every workgroup has at least 156 (phase 7) / 268 (phase 20) tile slots");
__device__ __forceinline__ void cv_decode(const Args& a, int it, const float*& W, bf16*& WT, int& K, int& N, int& swi, int& kb, int& nb) {
    unsigned char* ws = a.ws; int r; swi = 0;
#define CV_CASE(lim, base, Wp, WTp, Kv, Nv, sw) if (it < (lim)) { r = it - (base); W = (Wp); WT = (bf16*)(WTp); K = (Kv); N = (Nv); swi = (sw); kb = r / ((Nv) / 64); nb = r - kb * ((Nv) / 64); }
    CV_CASE(CV_E0, 0, a.in[7], ws + WS_WT1, DM, 2 * DFF, 1)
    else CV_CASE(CV_E1, CV_E0, a.in[8], ws + WS_WT2, DFF, DM, 0)
    else CV_CASE(CV_E2, CV_E1, a.in[9], ws + WS_WIN, DM, EVN, 0)
    else CV_CASE(CV_E3, CV_E2, a.in[10], ws + WS_WOUT, DM, DM, 0)
    else CV_CASE(CV_E4, CV_E3, a.in[7] + (size_t)1 * DM * 2 * DFF, ws + WS_WT1 + (size_t)1 * WT1_SZ, DM, 2 * DFF, 1)
    else CV_CASE(CV_E5, CV_E4, a.in[8] + (size_t)1 * DFF * DM, ws + WS_WT2 + (size_t)1 * WT2_SZ, DFF, DM, 0)
    else CV_CASE(CV_E6, CV_E5, a.in[7] + (size_t)2 * DM * 2 * DFF, ws + WS_WT1 + (size_t)2 * WT1_SZ, DM, 2 * DFF, 1)
    else CV_CASE(CV_E7, CV_E6, a.in[8] + (size_t)2 * DFF * DM, ws + WS_WT2 + (size_t)2 * WT2_SZ, DFF, DM, 0)
    else CV_CASE(CV_E8, CV_E7, a.in[16], ws + WS_WDOWN, DM, 1600, 0)
    else CV_CASE(CV_E9, CV_E8, a.in[19], ws + WS_WUQ, 1024, UQN, 0)
    else CV_CASE(CV_E10, CV_E9, a.in[20], ws + WS_WUKV, 512, UKVN, 0)
    else CV_CASE(CV_E11, CV_E10, a.in[25], ws + WS_WO, DM, DM, 0)
    else CV_CASE(CV_E12, CV_E11, a.in[7] + (size_t)3 * DM * 2 * DFF, ws + WS_WT1 + (size_t)3 * WT1_SZ, DM, 2 * DFF, 1)
    else { r = it - CV_E12; W = a.in[8] + (size_t)3 * DFF * DM; WT = (bf16*)(ws + WS_WT2 + (size_t)3 * WT2_SZ); K = DFF; N = DM; kb = r / (DM / 64); nb = r - kb * (DM / 64); }
#undef CV_CASE
}
__device__ __forceinline__ void p0_convert(const Args& a, LAS unsigned char* lds, int first, int last, int widx, int nw, int wave, int lane) {
    LAS float* scr = (LAS float*)(lds + wave * 16640);
    for (int it = first + widx; it < last; it += nw) {
        const float* W; bf16* WT; int K, N, swi, kb, nb; cv_decode(a, it, W, WT, K, N, swi, kb, nb);
        const int n0 = 64 * nb;
        int drow0 = n0;
        if (swi) { drow0 = n0 < DFF ? (n0 >> 7) * 256 + (n0 & 127) : ((n0 - DFF) >> 7) * 256 + 128 + ((n0 - DFF) & 127); }
        p0_transpose_item(W, K, N, WT, drow0, scr, 64 * kb, n0, lane);
    }
}
__device__ __forceinline__ void tail_convert(const Args& a, LAS unsigned char* lds, int nwg, int G, int c, int first, int count, int wave, int lane) {
    const int rem = nwg % G, nfree = rem == 0 ? G : G - rem, f = rem == 0 ? c : c - rem;
    if (f < 0) return;
    __syncthreads();
    p0_convert(a, lds, first, first + count, f * NWAVES + wave, nfree * NWAVES, wave, lane);
}
__device__ __forceinline__ float silu_f(float x) { return x / (1.0f + __expf(-x)); }
__device__ __forceinline__ void p0_mod(const Args& a, LAS unsigned char* lds, int c, int G, int tid) {
    LAS float* sl = (LAS float*)lds;
    LAS float* red = (LAS float*)(lds + 49152);
    for (int i = tid; i < 3 * DM; i += 512) { const int v = i >> 12, k = i & 4095; const float x = v < 2 ? a.in[1][v * DM + k] : a.in[3][k]; sl[i] = silu_f(x); }
    __syncthreads();
    const int cl = tid & 7, ks = tid >> 3;
    float* mod = (float*)(a.ws + WS_MOD);
    constexpr int NCG = NMOD * DM / 32;
    for (int u = c; u < 2 * NCG; u += G) {
        const int l = u / NCG, cg = u - l * NCG;
        const float* wp = a.in[5] + ((size_t)l * DM + ks * 64) * (NMOD * DM) + cg * 32 + cl * 4;
        f32x4 a0 = {0.f, 0.f, 0.f, 0.f}, a1 = a0, a2 = a0;
#pragma unroll 16
        for (int k = 0; k < 64; ++k) { const f32x4 w = __builtin_nontemporal_load((const f32x4*)(wp + (size_t)k * (NMOD * DM))); const int kk = ks * 64 + k;
            a0 += w * sl[kk]; a1 += w * sl[DM + kk]; a2 += w * sl[2 * DM + kk]; }
        LAS float* rp = red + (ks * 8 + cl) * 12;
        *(LAS f32x4*)(rp) = a0; *(LAS f32x4*)(rp + 4) = a1; *(LAS f32x4*)(rp + 8) = a2;
        __syncthreads();
        if (tid < 96) { const int cl2 = tid & 7, comp = tid >> 3; float s = 0.f;
#pragma unroll 8
            for (int q2 = 0; q2 < 64; ++q2) s += red[(q2 * 8 + cl2) * 12 + comp];
            const int v = comp >> 2, e2 = comp & 3, col = cg * 32 + cl2 * 4 + e2;
            mod[((size_t)l * 3 + v) * (NMOD * DM) + col] = s + a.in[6][l * (NMOD * DM) + col]; }
        __syncthreads();
    }
}
__device__ __forceinline__ void p0_zero_pad(const Args& a, int c, int G, int tid) {
    const v4u z = {0u, 0u, 0u, 0u}; constexpr int PER = 192 * 64 * 2 / 16;
    for (int i = c * 512 + tid; i < 64 * PER; i += G * 512) { const int kb = i / PER, r = i - kb * PER;
        v4u* p = (v4u*)(a.ws + WS_WDOWN + ((((size_t)6 * 64 + kb) * 256 + 64) * 64) * 2); p[r] = z; }
}

__device__ __forceinline__ void modulate_phase(const float* src_lat, const float* src_ctx, const float* g, const float* modl  , int ishift, int iscale,
                                               bf16* U, int M, int gw, int NGW, int lane, const float* slab, const float* sgate, float gs, float* hout_ctx, LAS unsigned char* lds) {
    const int M_wave = slab != nullptr ? NLAT : M;
    LAS float* gl = (LAS float*)(lds + 1024);
    { const int tid_ = (gw & 7) * 64 + lane;
      for (int i = tid_; i < 3 * (DM / 4); i += NWAVES * 64) { const int vec_ = i / (DM / 4), c4 = (i - vec_ * (DM / 4)) * 4;
          const f32x4 g4 = *(const f32x4*)(g + c4), sc4 = *(const f32x4*)(modl + ((size_t)vec_ * NMOD + iscale) * DM + c4), sh4 = *(const f32x4*)(modl + ((size_t)vec_ * NMOD + ishift) * DM + c4);
          *(LAS f32x4*)(gl + (vec_ * 2 + 0) * DM + c4) = g4 * (sc4 + 1.0f); *(LAS f32x4*)(gl + (vec_ * 2 + 1) * DM + c4) = sh4; }
      __syncthreads(); }
    if (slab != nullptr) {
        const int wv = gw & 7, blk = gw >> 3, nblk = NGW >> 3; LAS float* red = (LAS float*)lds;
        int par = 0;
        for (int r = blk; r < NCTXR; r += nblk) {
            const float* srow = src_ctx + (size_t)r * DM; const float* sp = slab + (size_t)r * DM; float* ho = hout_ctx + (size_t)r * DM;
            f32x4 hv[2], tt[2][8], gt[2];
#pragma unroll
            for (int q2 = 0; q2 < 2; ++q2) { const int ci = 4 * (lane + 64 * (2 * wv + q2)); hv[q2] = *(const f32x4*)(srow + ci); gt[q2] = *(const f32x4*)(sgate + ci);
#pragma unroll
                for (int s = 0; s < 8; ++s) tt[q2][s] = *(const f32x4*)(sp + (size_t)s * 512 * DM + ci); }
            float ss = 0.f;
#pragma unroll
            for (int q2 = 0; q2 < 2; ++q2) { const f32x4 sum = ((tt[q2][0] + tt[q2][1]) + (tt[q2][2] + tt[q2][3])) + ((tt[q2][4] + tt[q2][5]) + (tt[q2][6] + tt[q2][7]));
                hv[q2] += (gt[q2] * gs) * sum; ss += (hv[q2].x * hv[q2].x + hv[q2].y * hv[q2].y) + (hv[q2].z * hv[q2].z + hv[q2].w * hv[q2].w); }
#pragma unroll
            for (int q2 = 0; q2 < 2; ++q2) { const int ci = 4 * (lane + 64 * (2 * wv + q2)); *(f32x4*)(ho + ci) = hv[q2]; }
            ss = wave_sum(ss);
            if (lane == 0) red[par * 8 + wv] = ss;
            __syncthreads();
            float tot = 0.f;
#pragma unroll
            for (int w2 = 0; w2 < 8; ++w2) tot += red[par * 8 + w2];
            par ^= 1;
            const float rstd = 1.0f / sqrtf(tot * (1.0f / DM) + EPS);
            v2u* o8 = (v2u*)(U + (size_t)(NLAT + r) * DM);
#pragma unroll
            for (int q2 = 0; q2 < 2; ++q2) { const int ci = 4 * (lane + 64 * (2 * wv + q2));
                const f32x4 y = (hv[q2] * rstd) * *(const LAS f32x4*)(gl + 4 * DM + ci) + *(const LAS f32x4*)(gl + 5 * DM + ci);
                v2u w; w.x = pk2(y.x, y.y); w.y = pk2(y.z, y.w); o8[lane + 64 * (2 * wv + q2)] = w; }
        }
    }
    f32x4 vn[16];
    if (gw < M_wave) { const float* src0 = gw < NLAT ? src_lat + (size_t)gw * DM : src_ctx + (size_t)(gw - NLAT) * DM;
#pragma unroll
        for (int j = 0; j < 16; ++j) vn[j] = *(const f32x4*)(src0 + 4 * (lane + 64 * j)); }
    for (int row = gw; row < M_wave; row += NGW) {
        const int vec = row < SEQ ? 0 : (row < NLAT ? 1 : 2);
        f32x4 v[16]; float ss = 0.f;
#pragma unroll
        for (int j = 0; j < 16; ++j) v[j] = vn[j];
        { const int nrow = row + NGW;
          if (nrow < M_wave) { const float* srcn = nrow < NLAT ? src_lat + (size_t)nrow * DM : src_ctx + (size_t)(nrow - NLAT) * DM;
#pragma unroll
            for (int j = 0; j < 16; ++j) vn[j] = *(const f32x4*)(srcn + 4 * (lane + 64 * j)); } }
        __builtin_amdgcn_sched_barrier(0);
#pragma unroll
        for (int j = 0; j < 16; ++j) ss += (v[j].x * v[j].x + v[j].y * v[j].y) + (v[j].z * v[j].z + v[j].w * v[j].w);
        const float rstd = 1.0f / sqrtf(wave_sum(ss) * (1.0f / DM) + EPS);
        v2u* o8 = (v2u*)(U + (size_t)row * DM);
#pragma unroll
        for (int j = 0; j < 16; ++j) { const int ci = 4 * (lane + 64 * j);
            const f32x4 y = (v[j] * rstd) * *(const LAS f32x4*)(gl + (vec * 2 + 0) * DM + ci) + *(const LAS f32x4*)(gl + (vec * 2 + 1) * DM + ci);
            v2u w; w.x = pk2(y.x, y.y); w.y = pk2(y.z, y.w); o8[lane + 64 * j] = w; }
        __builtin_amdgcn_sched_barrier(0);
    }
}

__device__ __forceinline__ void rope_cs(float pos, int f, float l2step  , float& c, float& s) {
    const float ang = pos * __builtin_amdgcn_exp2f(-(float)f * l2step);
    const float rev = ang * 0.15915494309189535f;
    s = __builtin_amdgcn_sinf(rev); c = __builtin_amdgcn_cosf(rev);
}
__device__ __forceinline__ void unpack8(const v4u w, float (&x)[8]) { x[0] = bflo(w.x); x[1] = bfhi(w.x); x[2] = bflo(w.y); x[3] = bfhi(w.y); x[4] = bflo(w.z); x[5] = bfhi(w.z); x[6] = bflo(w.w); x[7] = bfhi(w.w); }
__device__ __forceinline__ v4u pack8(const float (&x)[8]) { v4u w; w.x = pk2(x[0], x[1]); w.y = pk2(x[2], x[3]); w.z = pk2(x[4], x[5]); w.w = pk2(x[6], x[7]); return w; }
__device__ __forceinline__ float sum16(float v) { v += __shfl_xor(v, 1); v += __shfl_xor(v, 2); v += __shfl_xor(v, 4); v += __shfl_xor(v, 8); return v; }

template <int KIND  >
__device__ __forceinline__ void prep_even_group(const v4u w, int lane, bool latent, float prow_f, float pcol_f, const f32x4 g0, const f32x4 g1, bf16* dst  , int dst_slot_stride) {
    const int i = lane & 15, sl = lane >> 4;
    bf16* d = dst + (size_t)sl * dst_slot_stride + i * 8;
    if constexpr (KIND == 3 || KIND == 5) { *(v4u*)d = w; return; }
    float x[8]; unpack8(w, x);
    float ss = 0.f;
#pragma unroll
    for (int e = 0; e < 8; ++e) ss += x[e] * x[e];
    const float rstd = 1.0f / sqrtf(sum16(ss) * (1.0f / 128.0f) + EPS);
    x[0] *= rstd * g0.x; x[1] *= rstd * g0.y; x[2] *= rstd * g0.z; x[3] *= rstd * g0.w; x[4] *= rstd * g1.x; x[5] *= rstd * g1.y; x[6] *= rstd * g1.z; x[7] *= rstd * g1.w;
    if constexpr (KIND == 1 || KIND == 4) {
        const int i8 = i & 7; const float pos = i8 < 4 ? prow_f : pcol_f; const int f0 = (i8 & 3) * 8;
#pragma unroll
        for (int e = 0; e < 8; ++e) { const float other = __shfl_xor(x[e], 8); float c, s; rope_cs(pos, f0 + e, 0.41524101186092029f, c, s);
            const float r = i < 8 ? x[e] * c - other * s : other * s + x[e] * c; x[e] = latent ? r : x[e]; }
    }
    *(v4u*)d = pack8(x);
}
__device__ __forceinline__ void prep_even_phase(const Args& a, int gw, int NGW, int lane) {
    unsigned char* ws = a.ws; const bf16* P = (const bf16*)(ws + WS_P);
    bf16* QB = (bf16*)(ws + WS_QB); bf16* KN = (bf16*)(ws + WS_KN); bf16* KG = (bf16*)(ws + WS_KG);
    const int gi_ = (lane & 15) * 8; const f32x4 z4 = {0.f, 0.f, 0.f, 0.f};
    const f32x4 nq0 = *(const f32x4*)(a.in[11] + gi_), nq1 = *(const f32x4*)(a.in[11] + gi_ + 4), gq0 = *(const f32x4*)(a.in[14] + gi_), gq1 = *(const f32x4*)(a.in[14] + gi_ + 4);
    const f32x4 nk0 = *(const f32x4*)(a.in[12] + gi_), nk1 = *(const f32x4*)(a.in[12] + gi_ + 4), gk0 = *(const f32x4*)(a.in[15] + gi_), gk1 = *(const f32x4*)(a.in[15] + gi_ + 4);
    for (int row = gw; row < MROWS; row += NGW) {
        const bool latent = row < NLAT; const int b = latent ? row >> 12 : (row - NLAT) >> 8; const int kidx = latent ? CTXL + (row & 4095) : (row - NLAT) & 255; const int t = row & 4095;
        const float prow_f = (float)(t >> 6), pcol_f = (float)(t & 63);
        const bf16* prow = P + (size_t)row * EVN; const size_t krow = (size_t)b * NKEY + kidx;
        v4u w[18];
#pragma unroll
        for (int grp = 0; grp < 18; ++grp) if (grp < 12 || grp == 16) w[grp] = *(const v4u*)(prow + grp * 512 + lane * 8);
#pragma unroll
        for (int grp = 0; grp < 4; ++grp) prep_even_group<0>(w[grp], lane, latent, prow_f, pcol_f, nq0, nq1, QB + (size_t)row * DM + grp * 512, 128);
#pragma unroll
        for (int grp = 4; grp < 8; ++grp) prep_even_group<1>(w[grp], lane, latent, prow_f, pcol_f, gq0, gq1, QB + (size_t)row * DM + grp * 512, 128);
#pragma unroll
        for (int grp = 8; grp < 12; ++grp) prep_even_group<2>(w[grp], lane, latent, prow_f, pcol_f, nk0, nk1, KN + krow * 2048 + (grp - 8) * 512, 128);
        prep_even_group<4>(w[16], lane, latent, prow_f, pcol_f, gk0, gk1, KG + krow * 512, 128);
    }
}

__device__ __forceinline__ void prep_mla1_phase(const Args& a, int gw, int NGW, int lane) {
    unsigned char* ws = a.ws; const float* DL = (const float*)(ws + WS_DL);
    bf16* CQN = (bf16*)(ws + WS_CQN); bf16* CKVN = (bf16*)(ws + WS_CKVN); bf16* KR = (bf16*)(ws + WS_KR);
    for (int row = gw; row < MROWS; row += NGW) {
        const float* d = DL + (size_t)row * DLN; const bool latent = row < NLAT; const int t = row & 4095;
        f32x4 q[4], kv[2], gq[4], gk[2]; float ss = 0.f;
#pragma unroll
        for (int j = 0; j < 4; ++j) { q[j] = *(const f32x4*)(d + 4 * (lane + 64 * j)); gq[j] = *(const f32x4*)(a.in[17] + 4 * (lane + 64 * j)); }
#pragma unroll
        for (int j = 0; j < 2; ++j) { kv[j] = *(const f32x4*)(d + 1024 + 4 * (lane + 64 * j)); gk[j] = *(const f32x4*)(a.in[18] + 4 * (lane + 64 * j)); }
        float x = d[1536 + lane]; const float gx = a.in[24][lane];
#pragma unroll
        for (int j = 0; j < 4; ++j) ss += (q[j].x * q[j].x + q[j].y * q[j].y) + (q[j].z * q[j].z + q[j].w * q[j].w);
        float rstd = 1.0f / sqrtf(wave_sum(ss) * (1.0f / 1024.0f) + EPS);
#pragma unroll
        for (int j = 0; j < 4; ++j) { const int ci = 4 * (lane + 64 * j); const f32x4 y = q[j] * rstd * gq[j];
            v2u w; w.x = pk2(y.x, y.y); w.y = pk2(y.z, y.w); *(v2u*)(CQN + (size_t)row * 1024 + ci) = w; }
        ss = 0.f;
#pragma unroll
        for (int j = 0; j < 2; ++j) ss += (kv[j].x * kv[j].x + kv[j].y * kv[j].y) + (kv[j].z * kv[j].z + kv[j].w * kv[j].w);
        rstd = 1.0f / sqrtf(wave_sum(ss) * (1.0f / 512.0f) + EPS);
#pragma unroll
        for (int j = 0; j < 2; ++j) { const int ci = 4 * (lane + 64 * j); const f32x4 y = kv[j] * rstd * gk[j];
            v2u w; w.x = pk2(y.x, y.y); w.y = pk2(y.z, y.w); *(v2u*)(CKVN + (size_t)row * 512 + ci) = w; }
        rstd = 1.0f / sqrtf(wave_sum(x * x) * (1.0f / 64.0f) + EPS);
        x = x * rstd * gx;
        { const int aidx = lane & 31; const float pos = aidx < 16 ? (float)(t >> 6) : (float)(t & 63); float c, s; rope_cs(pos, aidx & 15, 0.83048202372184058f, c, s);
          const float other = __shfl_xor(x, 32); const float r = lane < 32 ? x * c - other * s : other * s + x * c; x = latent ? r : x; }
        KR[(size_t)row * 64 + lane] = (bf16)f2bf(x);
    }
}
__device__ __forceinline__ void prep_mla2_phase(const Args& a, int gw, int NGW, int lane) {
    unsigned char* ws = a.ws; const bf16* QRAW = (const bf16*)(ws + WS_QRAW); const bf16* KVRAW = (const bf16*)(ws + WS_KVRAW); const bf16* KR = (const bf16*)(ws + WS_KR);
    bf16* QM = (bf16*)(ws + WS_QM); bf16* KM = (bf16*)(ws + WS_KM);
    const int i = lane & 15, g4 = lane >> 4;
    {
        const f32x4 gn0 = *(const f32x4*)(a.in[21] + i * 8), gn1 = *(const f32x4*)(a.in[21] + i * 8 + 4);
        const int i8 = i & 7; const f32x4 gr0 = *(const f32x4*)(a.in[22] + i8 * 8), gr1 = *(const f32x4*)(a.in[22] + i8 * 8 + 4);
        const int i4 = i & 3; const int f0 = (i4 & 1) * 8;
        v4u nn[8], nr[8];
        if (gw < NLAT) { const bf16* src0 = QRAW + (size_t)gw * UQN;
#pragma unroll
            for (int it = 0; it < 8; ++it) { const int h = it * 4 + g4; nn[it] = *(const v4u*)(src0 + h * 192 + i * 8); nr[it] = *(const v4u*)(src0 + h * 192 + 128 + i8 * 8); } }
        for (int row = gw; row < NLAT; row += NGW) {
            const int t = row & 4095; bf16* dst = QM + (size_t)row * UQN;
            const float pos = i4 < 2 ? (float)(t >> 6) : (float)(t & 63);
            v4u wn[8], wr[8];
#pragma unroll
            for (int it = 0; it < 8; ++it) { wn[it] = nn[it]; wr[it] = nr[it]; }
            if (row + NGW < NLAT) { const bf16* srcn = QRAW + (size_t)(row + NGW) * UQN;
#pragma unroll
                for (int it = 0; it < 8; ++it) { const int h = it * 4 + g4; nn[it] = *(const v4u*)(srcn + h * 192 + i * 8); nr[it] = *(const v4u*)(srcn + h * 192 + 128 + i8 * 8); } }
            __builtin_amdgcn_sched_barrier(0);
#pragma unroll
            for (int it = 0; it < 8; ++it) { const int h = it * 4 + g4;
                float x[8]; unpack8(wn[it], x);
                float ss = 0.f;
#pragma unroll
                for (int e = 0; e < 8; ++e) ss += x[e] * x[e];
                float rstd = 1.0f / sqrtf(sum16(ss) * (1.0f / 128.0f) + EPS);
                x[0] *= rstd * gn0.x; x[1] *= rstd * gn0.y; x[2] *= rstd * gn0.z; x[3] *= rstd * gn0.w; x[4] *= rstd * gn1.x; x[5] *= rstd * gn1.y; x[6] *= rstd * gn1.z; x[7] *= rstd * gn1.w;
                *(v4u*)(dst + h * 192 + i * 8) = pack8(x);
                float y[8]; unpack8(wr[it], y);
                ss = 0.f;
#pragma unroll
                for (int e = 0; e < 8; ++e) ss += y[e] * y[e];
                ss = i < 8 ? ss : 0.f;
                rstd = 1.0f / sqrtf(sum16(ss) * (1.0f / 64.0f) + EPS);
                y[0] *= rstd * gr0.x; y[1] *= rstd * gr0.y; y[2] *= rstd * gr0.z; y[3] *= rstd * gr0.w; y[4] *= rstd * gr1.x; y[5] *= rstd * gr1.y; y[6] *= rstd * gr1.z; y[7] *= rstd * gr1.w;
#pragma unroll
                for (int e = 0; e < 8; ++e) { const float other = __shfl_xor(y[e], 4); float c, s; rope_cs(pos, f0 + e, 0.83048202372184058f, c, s);
                    y[e] = i8 < 4 ? y[e] * c - other * s : other * s + y[e] * c; }
                if (i < 8) *(v4u*)(dst + h * 192 + 128 + i * 8) = pack8(y);
            }
            __builtin_amdgcn_sched_barrier(0);
        }
    }
    {
        const f32x4 gn0 = *(const f32x4*)(a.in[23] + i * 8), gn1 = *(const f32x4*)(a.in[23] + i * 8 + 4);
        v4u nk[8], nkr;
        if (gw < MROWS) { const bf16* src0 = KVRAW + (size_t)gw * UKVN; nkr = *(const v4u*)(KR + (size_t)gw * 64 + (i & 7) * 8);
#pragma unroll
            for (int it = 0; it < 8; ++it) { const int h = it * 4 + g4; nk[it] = *(const v4u*)(src0 + h * 256 + i * 8); } }
        for (int row = gw; row < MROWS; row += NGW) {
            const bool latent = row < NLAT; const int b = latent ? row >> 12 : (row - NLAT) >> 8; const int kidx = latent ? CTXL + (row & 4095) : (row - NLAT) & 255;
            const size_t krow = (size_t)b * NKEY + kidx; bf16* kd = KM + krow * UQN;
            v4u wk[8]; const v4u krw = nkr;
#pragma unroll
            for (int it = 0; it < 8; ++it) wk[it] = nk[it];
            if (row + NGW < MROWS) { const bf16* srcn = KVRAW + (size_t)(row + NGW) * UKVN; nkr = *(const v4u*)(KR + (size_t)(row + NGW) * 64 + (i & 7) * 8);
#pragma unroll
                for (int it = 0; it < 8; ++it) { const int h = it * 4 + g4; nk[it] = *(const v4u*)(srcn + h * 256 + i * 8); } }
            __builtin_amdgcn_sched_barrier(0);
#pragma unroll
            for (int it = 0; it < 8; ++it) { const int h = it * 4 + g4;
                float x[8]; unpack8(wk[it], x);
                float ss = 0.f;
#pragma unroll
                for (int e = 0; e < 8; ++e) ss += x[e] * x[e];
                const float rstd = 1.0f / sqrtf(sum16(ss) * (1.0f / 128.0f) + EPS);
                x[0] *= rstd * gn0.x; x[1] *= rstd * gn0.y; x[2] *= rstd * gn0.z; x[3] *= rstd * gn0.w; x[4] *= rstd * gn1.x; x[5] *= rstd * gn1.y; x[6] *= rstd * gn1.z; x[7] *= rstd * gn1.w;
                *(v4u*)(kd + h * 192 + i * 8) = pack8(x);
                if (i < 8) *(v4u*)(kd + h * 192 + 128 + i * 8) = krw;
            }
            __builtin_amdgcn_sched_barrier(0);
        }
    }
}

constexpr int CVS_OFF = 90112;
constexpr int CVS_TAB = CVS_OFF + 3 * 16384, CVS_MAXN = (LDSCTL_OFF - CVS_TAB) / 24;
__device__ __forceinline__ unsigned cv_pk(float lo, float hi) { unsigned r; asm("v_cvt_pk_bf16_f32 %0, %1, %2" : "=v"(r) : "v"(lo), "v"(hi)); return r; }
struct CvSide {
    LAS unsigned char* scr; int idx, n, bi; bf16* d0; bf16* d1; bf16* d2;
    __device__ __forceinline__ void init(const Args& a, LAS unsigned char* lds, int first, int count, int c, int G, int tid) {
        scr = lds + CVS_OFF; n = c < count ? (count - c + G - 1) / G : 0; idx = 0; bi = 0; d0 = nullptr; d1 = nullptr; d2 = nullptr;
        LAS unsigned* tab = (LAS unsigned*)(lds + CVS_TAB);
        __syncthreads();
        for (int i = tid; i < n; i += NWAVES * 64) {
            const float* W; bf16* WT; int K, N, swi, kb, nb; cv_decode(a, first + c + i * G, W, WT, K, N, swi, kb, nb);
            const int n0 = 64 * nb; int drow0 = n0;
            if (swi) { drow0 = n0 < DFF ? (n0 >> 7) * 256 + (n0 & 127) : ((n0 - DFF) >> 7) * 256 + 128 + ((n0 - DFF) & 127); }
            const unsigned long long sp = (unsigned long long)(W + (size_t)(64 * kb) * N + n0), dp = (unsigned long long)(WT + (((size_t)(drow0 >> 8) * (K >> 6) + kb) * 256 + (drow0 & 255)) * 64);
            tab[i * 6 + 0] = (unsigned)sp; tab[i * 6 + 1] = (unsigned)(sp >> 32); tab[i * 6 + 2] = (unsigned)dp; tab[i * 6 + 3] = (unsigned)(dp >> 32); tab[i * 6 + 4] = (unsigned)N * 4u; tab[i * 6 + 5] = 0u;
        }
        __syncthreads();
    }
    __device__ __forceinline__ void emit(bf16* dst, int buf, int t) {
        const int nn = t >> 3, cc = t & 7; const LAS float* s = (const LAS float*)(scr + buf * 16384 + (nn >> 2) * 128 + cc * 16 + (nn & 3) * 4);
        v4u o; o.x = cv_pk(s[0 * 512], s[1 * 512]); o.y = cv_pk(s[2 * 512], s[3 * 512]); o.z = cv_pk(s[4 * 512], s[5 * 512]); o.w = cv_pk(s[6 * 512], s[7 * 512]);
        __builtin_nontemporal_store(o, (GAS v4u*)(dst + (size_t)t * 8));
    }
    __device__ __forceinline__ bool step_emit(int tid, bool emitter) {
        if (d0 == nullptr) return false;
        if (emitter) { emit(d0, bi, tid); emit(d0, bi, tid + 256); }
        d0 = nullptr; return true;
    }
    __device__ __forceinline__ bool step_load(int tid, bool issuer) {
        if (idx >= n) { d0 = d1; d1 = d2; d2 = nullptr; bi = bi == 2 ? 0 : bi + 1; return false; }
        const LAS unsigned* e = (const LAS unsigned*)(scr + (CVS_TAB - CVS_OFF)) + idx * 6; ++idx;
        const unsigned t0 = __builtin_amdgcn_readfirstlane(e[2]), t1 = __builtin_amdgcn_readfirstlane(e[3]);
        bf16* dn = (bf16*)(((unsigned long long)t1 << 32) | t0);
        if (issuer) {
            const unsigned s0 = __builtin_amdgcn_readfirstlane(e[0]), s1 = __builtin_amdgcn_readfirstlane(e[1]), rs = __builtin_amdgcn_readfirstlane(e[4]);
            const char* src = (const char*)(((unsigned long long)s1 << 32) | s0);
            const int lane = tid & 63, wq = __builtin_amdgcn_readfirstlane((tid >> 6) & 3);
            const char* lp = src + (unsigned)((8 * (lane & 7) + 2 * wq) * rs + 16 * (lane >> 3));
            LAS unsigned char* lb = scr + bi * 16384 + wq * 4096;
            __builtin_amdgcn_global_load_lds((const unsigned*)lp, (LAS unsigned*)lb, 16, 0, 2);
            __builtin_amdgcn_global_load_lds((const unsigned*)(lp + 128), (LAS unsigned*)(lb + 1024), 16, 0, 2);
            __builtin_amdgcn_global_load_lds((const unsigned*)(lp + rs), (LAS unsigned*)(lb + 2048), 16, 0, 2);
            __builtin_amdgcn_global_load_lds((const unsigned*)(lp + rs + 128), (LAS unsigned*)(lb + 3072), 16, 0, 2);
        }
        d0 = d1; d1 = d2; d2 = dn; bi = bi == 2 ? 0 : bi + 1;
        return true;
    }
    __device__ __forceinline__ void flush(int tid) {
        asm volatile("s_waitcnt vmcnt(0)" ::: "memory"); __syncthreads();
        if (d0 != nullptr) emit(d0, bi, tid);
        if (d1 != nullptr) emit(d1, bi == 2 ? 0 : bi + 1, tid);
        if (d2 != nullptr) emit(d2, bi == 0 ? 2 : bi - 1, tid);
        d0 = nullptr; d1 = nullptr; d2 = nullptr;
    }
};
static_assert((CV_A7 + 255) / 256 <= CVS_MAXN && (CV_A20 + 255) / 256 <= CVS_MAXN, "attention side stream: the item table of one workgroup fits its LDS slot");
__device__ __forceinline__ void attn_even_phase(const Args& a, unsigned char* lds_g, LAS unsigned char* lds, int c, int G, int tid) {
    unsigned char* ws = a.ws; const bf16* QB = (const bf16*)(ws + WS_QB); const bf16* KN = (const bf16*)(ws + WS_KN); const bf16* VN = (const bf16*)(ws + WS_VN);
    const bf16* KG = (const bf16*)(ws + WS_KG); const bf16* PV = (const bf16*)(ws + WS_P); bf16* AO = (bf16*)(ws + WS_AO);
    const int wave = tid >> 6, lane = tid & 63;
    LAS float* rpbS = (LAS float*)(lds + att::Cfg<128>::SHM_RPB);
    CvSide sd; sd.init(a, lds, CV_S7, CV_A7, c, G, tid);
    for (int gi = c; gi < 1088; gi += G) {
        const bf16 *Qp, *Kp, *Vp; bf16* Op; int ldk, NT, seg2 = 0, bb; att::NaWave nw; nw.na = 0; nw.r0w = 0; nw.rq = 0; nw.cq = 0; nw.c0 = 0; nw.rlo = 0; nw.rpb = rpbS;
        if (gi < 512) {
            const int xg = gi & 7, u = gi >> 3, b = xg >> 2, kvh = xg & 3, h = kvh * 4 + (u >> 4), qb = u & 15;
            const size_t qrow = (size_t)b * SEQ + qb * 256;
            Qp = QB + qrow * DM + 2048 + h * 128; Op = AO + qrow * DM + 2048 + h * 128; Kp = KG + (size_t)b * NKEY * 512 + kvh * 128; Vp = PV + 17 * 512 + kvh * 128; ldk = 512; NT = NKEY / 64; bb = b;
        } else if (gi < 1024) {
            const int L = gi - 512, xg = L & 7, u = L >> 3, pair = xg * 4 + (u >> 4), Rg = u & 15, b = pair >> 4, h = pair & 15;
            const size_t qrow = (size_t)b * SEQ + Rg * 256;
            Qp = QB + qrow * DM + h * 128; Op = AO + qrow * DM + h * 128; Kp = KN + (size_t)b * NKEY * 2048 + h * 128; Vp = PV + 12 * 512 + h * 128; ldk = 2048; bb = b;
            const int rlo = min(max(4 * Rg - 4, 0), 56), nb = (Rg == 0 || Rg == 15) ? 8 : 12;
            NT = 4 + nb; seg2 = rlo * 64;
            const int rq = 4 * Rg + (wave >> 1), cq = (wave & 1) * 32 + (lane & 31);
            nw.na = 1; nw.rq = rq; nw.r0w = min(max(rq - 4, 0), 56); nw.cq = cq; nw.c0 = min(max(cq - 8, 0), 48); nw.rlo = rlo;
            __syncthreads();
            if (tid < 465) rpbS[tid] = a.in[13][h * 465 + tid] * (1.0f / att::Cfg<128>::SCALE);
        } else {
            const int L = gi - 1024, ty = L >> 5, b = (L >> 4) & 1, h = L & 15;
            const size_t qrow = (size_t)NLAT + b * CTXL;
            if (ty == 0) { Qp = QB + qrow * DM + h * 128; Op = AO + qrow * DM + h * 128; Kp = KN + (size_t)b * NKEY * 2048 + h * 128; Vp = PV + 12 * 512 + h * 128; ldk = 2048; }
            else { Qp = QB + qrow * DM + 2048 + h * 128; Op = AO + qrow * DM + 2048 + h * 128; Kp = KG + (size_t)b * NKEY * 512 + (h >> 2) * 128; Vp = PV + 17 * 512 + (h >> 2) * 128; ldk = 512; }
            NT = 4; bb = b;
        }
        att::attn_body<128, true, CvSide>(Qp, DM, Kp, ldk, Vp, EVN, Op, DM, NT, seg2, NLAT + bb * CTXL, bb * SEQ - CTXL, nw, (char*)lds_g, sd);
    }
    sd.flush(tid);
}
__device__ __forceinline__ void attn_mla_phase(const Args& a, unsigned char* lds_g, LAS unsigned char* lds, int c, int G) {
    unsigned char* ws = a.ws; const bf16* QM = (const bf16*)(ws + WS_QM); const bf16* KM = (const bf16*)(ws + WS_KM); const bf16* KVR = (const bf16*)(ws + WS_KVRAW); bf16* AO = (bf16*)(ws + WS_AO);
    att::NaWave nw; nw.na = 0; nw.r0w = 0; nw.rq = 0; nw.cq = 0; nw.c0 = 0; nw.rlo = 0; nw.rpb = nullptr;
    CvSide sd; sd.init(a, lds, CV_S20, CV_A20, c, G, (int)threadIdx.x);
    for (int gi = c; gi < 1024; gi += G) {
        const int xg = gi & 7, u = gi >> 3, pair = xg * 8 + (u >> 4), qb = u & 15, b = pair >> 5, h = pair & 31;
        const size_t qrow = (size_t)b * SEQ + qb * 256;
        att::attn_body<192, false, CvSide>(QM + qrow * UQN + h * 192, UQN, KM + (size_t)b * NKEY * UQN + h * 192, UQN, KVR + h * 256 + 128, UKVN, AO + qrow * DM + h * 128, DM, NKEY / 64, 0, NLAT + b * CTXL, b * SEQ - CTXL, nw, (char*)lds_g, sd);
    }
    sd.flush((int)threadIdx.x);
}
constexpr int NPHASE = 25;
__global__ void __launch_bounds__(NWAVES * 64, 2) fwd_kernel(Args args) {
    extern __shared__ __attribute__((aligned(16))) unsigned char lds_g[];
    LAS unsigned char* lds = (LAS unsigned char*)lds_g;
    const int tid = threadIdx.x, lane = tid & 63, wave = __builtin_amdgcn_readfirstlane(tid >> 6);
    const int G = gridDim.x, c = blockIdx.x;
    const int vcu = (G % 8 == 0) ? (c % 8) * (G / 8) + c / 8 : c;
    const int gw = vcu * NWAVES + wave, NGW = G * NWAVES;
    unsigned char* ws = args.ws;
    volatile LAS unsigned* MISC = (volatile LAS unsigned*)(lds + MISC_OFF);
    for (int u = tid; u < (LDS_BYTES - LDSCTL_OFF) / 4; u += NWAVES * 64) ((LAS unsigned*)(lds + LDSCTL_OFF))[u] = 0u;
    __syncthreads();
    XcdBarrier bar; bar.bar = (unsigned*)(ws + WS_CTL) + CW_BAR; bar.x = 0; bar.st = nullptr;
    if (ONE_LAUNCH) bar = xcd_barrier_post((unsigned*)(ws + WS_CTL) + CW_BAR, MISC + 8);
    const int lo = args.ph_lo, hi = args.ph_hi;
#define IN(k) (lo <= (k) && (k) < hi)
#define PH_BEGIN(k) if (IN(k))
    constexpr int FFN1_NMAJ = 4, INP_NMAJ = 0, RES_NMAJ = 0;
#define SEAM(k) do { if (ONE_LAUNCH && IN(k) && IN((k) + 1)) xcd_barrier(bar); } while (0)
    float* MOD = (float*)(ws + WS_MOD);
    bf16* U = (bf16*)(ws + WS_U); bf16* HID = (bf16*)(ws + WS_HID); bf16* AO = (bf16*)(ws + WS_AO);
    float* HA = (float*)(ws + WS_HA); float* HB = (float*)(ws + WS_HB);
    const float* X = args.in[0]; const float* CTXI = args.in[2]; const float* NG = args.in[4];
    const float* MOD0 = MOD; const float* MOD1 = MOD + 3 * NMOD * DM;
    float* SLAB = (float*)(ws + WS_SLAB); const float* NOSLAB = nullptr;
    const float* GC0 = MOD0 + (size_t)2 * NMOD * DM; const float* GC1 = MOD1 + (size_t)2 * NMOD * DM;

#define PH_MODULATE(k, srcl, srcc, gptr, modl, ish, isc, Mrows, slabp, sgatep, gsv, houtc) PH_BEGIN(k) { modulate_phase(srcl, srcc, gptr, modl, ish, isc, U, Mrows, gw, NGW, lane, slabp, sgatep, gsv, houtc, lds); } SEAM(k);
#define PH_FFN1(k, widx, Mrows, cvfirst, cvcount) PH_BEGIN(k) { pg8::Gemm g{U, (const bf16*)(ws + WS_WT1 + (size_t)(widx) * WT1_SZ), Mrows, 2 * DFF, DM, DM, 0}; pg8::StaticOrder S; S.init(Mrows, 2 * DFF, G, c, DM, FFN1_NMAJ); \
        pg8::EpiSwiglu E{HID, DFF}; pg8::gemm_phase<pg8::EpiSwiglu, pg8::StaticOrder, PG8_ALIGN, PG8_SP2>(lds, g, S, E); \
        if ((cvcount) > 0) tail_convert(args, lds, ((Mrows) / 256) * (2 * DFF / 256), G, c, cvfirst, cvcount, wave, lane); } SEAM(k);
#define PH_RESID(k, Aptr, Wptr, Kdim, Mrows, rl, rc, outp, gatep, gsv) PH_BEGIN(k) { pg8::Gemm g{Aptr, (const bf16*)(Wptr), Mrows, DM, Kdim, Kdim, 0}; pg8::StaticOrder S; S.init(Mrows, DM, G, c, Kdim, RES_NMAJ); \
        pg8::EpiResid E{rl, rc, outp, gatep, gsv}; pg8::gemm_phase<pg8::EpiResid, pg8::StaticOrder, PG8_ALIGN, PG8_SP2>(lds, g, S, E); } SEAM(k);
#define PH_RESID_SPLIT(k, Aptr, Wptr, Kdim, rl, rc, outp, gatep, gsv) PH_BEGIN(k) { pg8::Gemm g{Aptr, (const bf16*)(Wptr), MROWS, DM, Kdim, Kdim, 0}; pg8::SplitOrder S; S.init(G, c, Kdim); \
        pg8::EpiResidSplit E{{rl, rc, outp, gatep, gsv}, SLAB}; pg8::gemm_phase<pg8::EpiResidSplit, pg8::SplitOrder, PG8_ALIGN, PG8_SP2>(lds, g, S, E); } SEAM(k);

    PH_BEGIN(0) { p0_convert(args, lds, 0, CV_P0, gw, NGW, wave, lane); p0_zero_pad(args, c, G, tid); __syncthreads(); p0_mod(args, lds, c, G, tid); } SEAM(0);

    PH_MODULATE(1, X, CTXI, NG + 0 * DM, MOD0, 0, 1, MROWS, NOSLAB, NOSLAB, 0.f, (float*)nullptr)
    PH_FFN1(2, 0, MROWS, CV_S2, CV_T2)
    PH_RESID_SPLIT(3, HID, ws + WS_WT2 + 0 * WT2_SZ, DFF, X, CTXI, HA, MOD0 + 2 * DM, 0.5f)
    PH_MODULATE(4, HA, CTXI, NG + 1 * DM, MOD0, 3, 4, MROWS, SLAB, GC0 + 2 * DM, 0.5f, HA + (size_t)NLAT * DM)
    PH_BEGIN(5) { pg8::Gemm g{U, (const bf16*)(ws + WS_WIN), MROWS, EVN, DM, DM, 0}; pg8::StaticOrder S; S.init(MROWS, EVN, G, c, DM, INP_NMAJ);
        pg8::EpiBf16P E{(bf16*)(ws + WS_P), EVN}; pg8::gemm_phase<pg8::EpiBf16P, pg8::StaticOrder, PG8_ALIGN, PG8_SP2>(lds, g, S, E);
        tail_convert(args, lds, (MROWS / 256) * (EVN / 256), G, c, CV_S5, CV_T5, wave, lane); } SEAM(5);
    PH_BEGIN(6) { prep_even_phase(args, gw, NGW, lane); } SEAM(6);
    PH_BEGIN(7) { attn_even_phase(args, lds_g, lds, c, G, tid); } SEAM(7);
    PH_RESID_SPLIT(8, AO, ws + WS_WOUT, DM, HA, HA + (size_t)NLAT * DM, HB, MOD0 + 5 * DM, 1.0f)
    PH_MODULATE(9, HB, HA + (size_t)NLAT * DM, NG + 2 * DM, MOD0, 6, 7, MROWS, SLAB, GC0 + 5 * DM, 1.0f, HB + (size_t)NLAT * DM)
    PH_FFN1(10, 1, MROWS, CV_S10, CV_T10)
    PH_RESID_SPLIT(11, HID, ws + WS_WT2 + 1 * WT2_SZ, DFF, HB, HB + (size_t)NLAT * DM, HA, MOD0 + 8 * DM, 0.5f)

    PH_MODULATE(12, HA, HB + (size_t)NLAT * DM, NG + 3 * DM, MOD1, 0, 1, MROWS, SLAB, GC0 + 8 * DM, 0.5f, HA + (size_t)NLAT * DM)
    PH_FFN1(13, 2, MROWS, CV_S13, CV_T13)
    PH_RESID_SPLIT(14, HID, ws + WS_WT2 + 2 * WT2_SZ, DFF, HA, HA + (size_t)NLAT * DM, HB, MOD1 + 2 * DM, 0.5f)
    PH_MODULATE(15, HB, HA + (size_t)NLAT * DM, NG + 4 * DM, MOD1, 3, 4, MROWS, SLAB, GC1 + 2 * DM, 0.5f, HB + (size_t)NLAT * DM)
    PH_BEGIN(16) { pg8::Gemm g{U, (const bf16*)(ws + WS_WDOWN), MROWS, DLN, DM, DM, 0}; pg8::StaticOrder S; S.init(MROWS, DLN, G, c, DM);
        pg8::EpiF32P E{(float*)(ws + WS_DL), DLN}; pg8::gemm_phase<pg8::EpiF32P, pg8::StaticOrder, PG8_ALIGN, PG8_SP2>(lds, g, S, E);
        tail_convert(args, lds, (MROWS / 256) * (DLN / 256), G, c, CV_S16, CV_T16, wave, lane); } SEAM(16);
    PH_BEGIN(17) { prep_mla1_phase(args, gw, NGW, lane); } SEAM(17);
    PH_BEGIN(18) {
        { pg8::Gemm g{(const bf16*)(ws + WS_CQN), (const bf16*)(ws + WS_WUQ), NLAT, UQN, 1024, 1024, 0}; pg8::StaticOrder S; S.init(NLAT, UQN, G, c, 1024);
          pg8::EpiBf16P E{(bf16*)(ws + WS_QRAW), UQN}; pg8::gemm_phase<pg8::EpiBf16P, pg8::StaticOrder, PG8_ALIGN, PG8_SP2>(lds, g, S, E); }
        { pg8::Gemm g{(const bf16*)(ws + WS_CKVN), (const bf16*)(ws + WS_WUKV), MROWS, UKVN, 512, 512, 0}; pg8::StaticOrder S; S.init(MROWS, UKVN, G, c, 512);
          pg8::EpiBf16P E{(bf16*)(ws + WS_KVRAW), UKVN}; pg8::gemm_phase<pg8::EpiBf16P, pg8::StaticOrder, PG8_ALIGN, PG8_SP2>(lds, g, S, E); }
        tail_convert(args, lds, (MROWS / 256) * (UKVN / 256), G, c, CV_S18, CV_T18, wave, lane);
    } SEAM(18);
    PH_BEGIN(19) { prep_mla2_phase(args, gw, NGW, lane); } SEAM(19);
    PH_BEGIN(20) { attn_mla_phase(args, lds_g, lds, c, G); } SEAM(20);
    PH_RESID(21, AO, ws + WS_WO, DM, NLAT, HB, HB, HA, MOD1 + 5 * DM, 1.0f)
    PH_MODULATE(22, HA, HA, NG + 5 * DM, MOD1, 6, 7, NLAT, NOSLAB, NOSLAB, 0.f, (float*)nullptr)
    PH_FFN1(23, 3, NLAT, 0, 0)
    PH_RESID(24, HID, ws + WS_WT2 + 3 * WT2_SZ, DFF, NLAT, HA, HA, args.out, MOD1 + 8 * DM, 0.5f)
#undef IN
#undef SEAM
}

extern "C" void kernel_launch(void* const* d_in, const int* in_sizes, int n_in, void* d_out, int out_size, void* d_ws, size_t ws_size, hipStream_t stream) {
    static int grid = 0;
    if (grid == 0) {
        if (n_in != 26 || out_size != NLAT * DM || ws_size < WS_END) { fprintf(stderr, "kernel_launch: unexpected shapes (n_in %d out %d ws %zu)\n", n_in, out_size, ws_size); grid = -1; return; }
        int dev = 0, cus = 0, per_cu = 0;
        if (hipGetDevice(&dev) != hipSuccess || hipDeviceGetAttribute(&cus, hipDeviceAttributeMultiprocessorCount, dev) != hipSuccess) { grid = -1; return; }
        if (hipFuncSetAttribute((const void*)fwd_kernel, hipFuncAttributeMaxDynamicSharedMemorySize, LDS_BYTES) != hipSuccess) { fprintf(stderr, "kernel_launch: hipFuncSetAttribute failed\n"); grid = -1; return; }
        if (hipOccupancyMaxActiveBlocksPerMultiprocessor(&per_cu, (const void*)fwd_kernel, NWAVES * 64, LDS_BYTES) != hipSuccess || per_cu < 1) { fprintf(stderr, "kernel_launch: occupancy query reports %d\n", per_cu); }
        (void)hipGetLastError();
        grid = cus;
    }
    if (grid < 0) return;
    (void)hipMemsetAsync((char*)d_ws + WS_CTL, 0, CTL_ZERO_BYTES, stream);
    Args a{};
    for (int i = 0; i < 26; ++i) a.in[i] = (const float*)d_in[i];
    a.out = (float*)d_out; a.ws = (unsigned char*)d_ws; a.chk = 0; a.pad = 0;
#if DBG
    (void)hipMemsetAsync((char*)d_ws + WS_DBG, 0, 4096, stream);
#define DBG_STEP(K) a.ph_lo = K; a.ph_hi = K + 1; hipLaunchKernelGGL(fwd_kernel, dim3(grid), dim3(NWAVES * 64), LDS_BYTES, stream, a); hipLaunchKernelGGL(check_kernel<K>, dim3(256), dim3(256), 0, stream, a);
    DBG_STEP(0) DBG_STEP(1) DBG_STEP(2) DBG_STEP(3) DBG_STEP(4) DBG_STEP(5) DBG_STEP(6) DBG_STEP(7) DBG_STEP(8) DBG_STEP(9) DBG_STEP(10) DBG_STEP(11) DBG_STEP(12)
    DBG_STEP(13) DBG_STEP(14) DBG_STEP(15) DBG_STEP(16) DBG_STEP(17) DBG_STEP(18) DBG_STEP(19) DBG_STEP(20) DBG_STEP(21) DBG_STEP(22) DBG_STEP(23) DBG_STEP(24)
    hipLaunchKernelGGL(dbg_sanitize, dim3(1024), dim3(256), 0, stream, a);
    hipLaunchKernelGGL(dbg_encode, dim3(1), dim3(64), 0, stream, a);
#elif ONE_LAUNCH
    a.ph_lo = 0; a.ph_hi = NPHASE;
    hipLaunchKernelGGL(fwd_kernel, dim3(grid), dim3(NWAVES * 64), LDS_BYTES, stream, a);
#else
    for (int k = 0; k < NPHASE; ++k) { a.ph_lo = k; a.ph_hi = k + 1; hipLaunchKernelGGL(fwd_kernel, dim3(grid), dim3(NWAVES * 64), LDS_BYTES, stream, a); }
#endif
}
```
